# Optimizing an MI355X kernel written in HIP

```python
import jax, jax.numpy as jnp
from jax import lax
import numpy as np

D_MODEL = 1024
BATCH = 4
SEQ = 4096
DEPTH = 2

N_HEADS = 4
HEAD_DIM = 64
MIX_W = N_HEADS * HEAD_DIM
N_MIXERS = 4
MIX_WIDTH = N_MIXERS * MIX_W
ROPE_THETA = 500000.0
ROPE_DIM = HEAD_DIM // 4
Q_BLOCK = 128
EPS = 1e-6
NEG = -1e30
BIG = 1e9
DIL_CONFIGS = ((128, 1), (512, 4), (2048, 16))
CMP_LEN = 32
CMP_STRIDE = 16
CMP_HID = 256
SEL_LEN = 64
SEL_TOPN = 16
WIN_LEN = 512
MOBA_BLOCK = 256
MOBA_TOPK = 3

IN_SPLITS = (
    MIX_W, MIX_W, MIX_W, MIX_W,
    MIX_W, MIX_W, MIX_W, MIX_W,
    MIX_W, HEAD_DIM, HEAD_DIM, HEAD_DIM, HEAD_DIM, HEAD_DIM, HEAD_DIM,
    3 * N_HEADS, MIX_W,
    MIX_W, MIX_W, MIX_W, MIX_W,
)
N_IN = sum(IN_SPLITS)

kernel_name = 'hybrid_parallel_sparse_mixers'


def rms_norm(x, g):
    xf = x.astype(jnp.float32)
    y = xf * lax.rsqrt(jnp.mean(xf * xf, axis=-1, keepdims=True) + EPS)
    return (y * g.astype(jnp.float32)).astype(x.dtype)


def rope_tables(pos):
    inv_freq = 1.0 / (ROPE_THETA ** (np.arange(0, ROPE_DIM, 2, dtype=np.float32) / ROPE_DIM))
    ang = jnp.asarray(pos, jnp.float32)[:, None] * jnp.asarray(inv_freq, jnp.float32)[None, :]
    return jnp.cos(ang), jnp.sin(ang)


def apply_rope(t, cos, sin):
    half = ROPE_DIM // 2
    c = cos.astype(t.dtype)
    s = sin.astype(t.dtype)
    t1 = t[..., :half]
    t2 = t[..., half:ROPE_DIM]
    return jnp.concatenate([t1 * c - t2 * s, t2 * c + t1 * s, t[..., ROPE_DIM:]], axis=-1)


def to_heads(t):
    B, S, _ = t.shape
    return t.reshape(B, S, N_HEADS, HEAD_DIM).transpose(0, 2, 1, 3)


def from_heads(t):
    B, H, S, dh = t.shape
    return t.transpose(0, 2, 1, 3).reshape(B, S, H * dh)


def sweep_query_blocks(block_fn, n_blocks):
    out = lax.map(block_fn, jnp.arange(n_blocks))
    nb, B, H, qb, dh = out.shape
    return out.transpose(1, 2, 0, 3, 4).reshape(B, H, nb * qb, dh)


def query_block(q, i):
    s0 = i * Q_BLOCK
    return s0, s0 + jnp.arange(Q_BLOCK), lax.dynamic_slice_in_dim(q, s0, Q_BLOCK, axis=2)


def stick_breaking_attention(q, k, v):
    S = q.shape[2]
    scale = HEAD_DIM ** -0.5
    kpos = jnp.arange(S)

    def block(i):
        s0, qpos, qb = query_block(q, i)
        z = jnp.einsum('bhqd,bhkd->bhqk', qb, k).astype(jnp.float32) * scale
        past = kpos[None, :] < qpos[:, None]
        log_rest = jnp.where(past, jax.nn.log_sigmoid(-z), 0.0)
        between = lax.cumsum(log_rest, axis=3, reverse=True) - log_rest
        a = jnp.where(past, jnp.exp(jax.nn.log_sigmoid(z) + between), 0.0)
        return jnp.einsum('bhqk,bhkd->bhqd', a.astype(v.dtype), v)

    return sweep_query_blocks(block, S // Q_BLOCK)


def dilated_window_attention(q, k, v):
    B, H, S, dh = q.shape
    scale = HEAD_DIM ** -0.5

    def block(i):
        s0, qpos, qb = query_block(q, i)
        outs, lses = [], []
        for window, dil in DIL_CONFIGS:
            n_keys = window // dil + 1
            idx = qpos[:, None] - dil * jnp.arange(n_keys)[None, :]
            valid = idx >= 0
            flat = jnp.maximum(idx, 0).reshape(-1)
            kg = jnp.take(k, flat, axis=2).reshape(B, H, Q_BLOCK, n_keys, dh)
            vg = jnp.take(v, flat, axis=2).reshape(B, H, Q_BLOCK, n_keys, dh)
            s = jnp.einsum('bhqd,bhqnd->bhqn', qb, kg).astype(jnp.float32) * scale
            s = jnp.where(valid, s, NEG)
            lse = jax.nn.logsumexp(s, axis=-1, keepdims=True)
            p = jnp.exp(s - lse)
            outs.append(jnp.einsum('bhqn,bhqnd->bhqd', p.astype(v.dtype), vg))
            lses.append(lse)
        w = jax.nn.softmax(jnp.concatenate(lses, axis=-1), axis=-1)
        o = jnp.stack(outs, axis=-1)
        return jnp.einsum('bhqdc,bhqc->bhqd', o, w.astype(o.dtype))

    return sweep_query_blocks(block, S // Q_BLOCK)


def compress_tokens(t, pos_emb, w1, b1, w2):
    B, S, dh = t.shape
    n_cmp = (S - CMP_LEN) // CMP_STRIDE + 1
    idx = np.arange(n_cmp)[:, None] * CMP_STRIDE + np.arange(CMP_LEN)[None, :]
    blocks = t[:, idx] + pos_emb
    hid = jax.nn.gelu(blocks.reshape(B, n_cmp, CMP_LEN * dh) @ w1 + b1)
    return hid @ w2


def nsa_attention(q, kc, vc, ks, vs, kw, vw, gates):
    B, H, S, dh = q.shape
    scale = HEAD_DIM ** -0.5
    n_cmp = kc.shape[1]
    n_sel = S // SEL_LEN
    n_top = min(SEL_TOPN, n_sel)
    c_start = np.arange(n_cmp) * CMP_STRIDE
    c_end = jnp.asarray(c_start + CMP_LEN - 1)
    s_start = np.arange(n_sel) * SEL_LEN
    overlap = np.clip(np.minimum(c_start[:, None] + CMP_LEN, s_start[None, :] + SEL_LEN)
                      - np.maximum(c_start[:, None], s_start[None, :]), 0, None) / CMP_LEN
    overlap = jnp.asarray(overlap, jnp.float32)
    ks_blk = ks.reshape(B, n_sel, SEL_LEN, dh)
    vs_blk = vs.reshape(B, n_sel, SEL_LEN, dh)
    kw_pad = jnp.pad(kw, ((0, 0), (WIN_LEN, 0), (0, 0)))
    vw_pad = jnp.pad(vw, ((0, 0), (WIN_LEN, 0), (0, 0)))
    blk_ids = jnp.arange(n_sel)
    gather_blocks = jax.vmap(lambda tb, idx: tb[idx])
    n_sel_keys = n_top * SEL_LEN

    def block(i):
        s0, qpos, qb = query_block(q, i)
        sc = jnp.einsum('bhqd,bnd->bhqn', qb, kc).astype(jnp.float32) * scale
        c_valid = c_end[None, :] <= qpos[:, None]
        pc = jax.nn.softmax(jnp.where(c_valid, sc, NEG), axis=-1) * c_valid
        o_cmp = jnp.einsum('bhqn,bnd->bhqd', pc.astype(vc.dtype), vc)
        imp = jnp.einsum('bhqn,ns->bqs', pc, overlap)
        own = qpos // SEL_LEN
        s_valid = blk_ids[None, :] <= own[:, None]
        forced = (blk_ids[None, :] == 0) | (blk_ids[None, :] >= own[:, None] - 1)
        imp = jnp.where(s_valid, jnp.where(forced, BIG, imp), NEG)
        _, sel = lax.top_k(imp, n_top)
        kg = gather_blocks(ks_blk, sel).reshape(B, Q_BLOCK, n_sel_keys, dh)
        vg = gather_blocks(vs_blk, sel).reshape(B, Q_BLOCK, n_sel_keys, dh)
        key_pos = (sel[..., None] * SEL_LEN + jnp.arange(SEL_LEN)).reshape(B, Q_BLOCK, n_sel_keys)
        sel_valid = key_pos <= qpos[None, :, None]
        ss = jnp.einsum('bhqd,bqmd->bhqm', qb, kg).astype(jnp.float32) * scale
        ps = jax.nn.softmax(jnp.where(sel_valid[:, None], ss, NEG), axis=-1)
        o_sel = jnp.einsum('bhqm,bqmd->bhqd', ps.astype(vg.dtype), vg)
        kwb = lax.dynamic_slice_in_dim(kw_pad, s0, Q_BLOCK + WIN_LEN, axis=1)
        vwb = lax.dynamic_slice_in_dim(vw_pad, s0, Q_BLOCK + WIN_LEN, axis=1)
        kpos = s0 - WIN_LEN + jnp.arange(Q_BLOCK + WIN_LEN)
        dist = qpos[:, None] - kpos[None, :]
        w_valid = (dist >= 0) & (dist < WIN_LEN) & (kpos[None, :] >= 0)
        sw = jnp.einsum('bhqd,bkd->bhqk', qb, kwb).astype(jnp.float32) * scale
        pw = jax.nn.softmax(jnp.where(w_valid, sw, NEG), axis=-1)
        o_win = jnp.einsum('bhqk,bkd->bhqd', pw.astype(vwb.dtype), vwb)
        g = lax.dynamic_slice_in_dim(gates, s0, Q_BLOCK, axis=2)
        return g[..., 0:1] * o_cmp + g[..., 1:2] * o_sel + g[..., 2:3] * o_win

    return sweep_query_blocks(block, S // Q_BLOCK)


def moba_attention(q, k, v):
    B, H, S, dh = q.shape
    scale = HEAD_DIM ** -0.5
    n_blk = -(-S // MOBA_BLOCK)
    pad = n_blk * MOBA_BLOCK - S
    kp = jnp.pad(k, ((0, 0), (0, 0), (0, pad), (0, 0)))
    vp = jnp.pad(v, ((0, 0), (0, 0), (0, pad), (0, 0)))
    k_blk = kp.reshape(B, H, n_blk, MOBA_BLOCK, dh)
    v_blk = vp.reshape(B, H, n_blk, MOBA_BLOCK, dh)
    k_mean = jnp.mean(k_blk.astype(jnp.float32), axis=3)
    n_top = min(MOBA_TOPK, max(n_blk - 1, 1))
    n_sel_keys = n_top * MOBA_BLOCK
    blk_ids = jnp.arange(n_blk)
    gather_blocks = jax.vmap(jax.vmap(lambda tb, idx: tb[idx]))

    def block(i):
        s0, qpos, qb = query_block(q, i)
        own = s0 // MOBA_BLOCK
        gsc = jnp.einsum('bhqd,bhnd->bhqn', qb.astype(jnp.float32), k_mean)
        gsc = jnp.where(blk_ids[None, :] < own, gsc, NEG)
        _, sel = lax.top_k(gsc, n_top)
        sel_valid = jnp.repeat(sel < own, MOBA_BLOCK, axis=-1)
        kg = gather_blocks(k_blk, sel).reshape(B, H, Q_BLOCK, n_sel_keys, dh)
        vg = gather_blocks(v_blk, sel).reshape(B, H, Q_BLOCK, n_sel_keys, dh)
        ss = jnp.einsum('bhqd,bhqmd->bhqm', qb, kg).astype(jnp.float32) * scale
        ss = jnp.where(sel_valid, ss, NEG)
        own_start = own * MOBA_BLOCK
        ko = lax.dynamic_slice_in_dim(kp, own_start, MOBA_BLOCK, axis=2)
        vo = lax.dynamic_slice_in_dim(vp, own_start, MOBA_BLOCK, axis=2)
        opos = own_start + jnp.arange(MOBA_BLOCK)
        so = jnp.einsum('bhqd,bhkd->bhqk', qb, ko).astype(jnp.float32) * scale
        so = jnp.where(opos[None, :] <= qpos[:, None], so, NEG)
        p = jax.nn.softmax(jnp.concatenate([ss, so], axis=-1), axis=-1)
        o_sel = jnp.einsum('bhqm,bhqmd->bhqd', p[..., :n_sel_keys].astype(vg.dtype), vg)
        o_own = jnp.einsum('bhqk,bhkd->bhqd', p[..., n_sel_keys:].astype(vo.dtype), vo)
        return o_sel + o_own

    return sweep_query_blocks(block, S // Q_BLOCK)


def hybrid_layer(x, c, norm_pre, norm_post, w_mod, b_mod, w_in, w_out,
                 cmp_pos, cmp_w1, cmp_b1, cmp_w2, cos, sin, cos_c, sin_c):
    B, S, _ = x.shape
    mod = jax.nn.silu(c) @ w_mod + b_mod
    shift, scale, gate = jnp.split(mod[:, None, :], 3, axis=-1)
    h = rms_norm(x, norm_pre) * (1 + scale) + shift
    proj = h @ w_in
    (qa, ka, va, za, qb, kb, vb, zb, qc, kcr, vcr, ksr, vsr, kwr, vwr, gc, zc,
     qd, kd, vd, zd) = jnp.split(proj, np.cumsum(IN_SPLITS)[:-1].tolist(), axis=-1)
    oa = stick_breaking_attention(to_heads(qa), to_heads(ka), to_heads(va))
    ob = dilated_window_attention(apply_rope(to_heads(qb), cos, sin),
                                  apply_rope(to_heads(kb), cos, sin), to_heads(vb))
    kc = apply_rope(compress_tokens(kcr, cmp_pos[0], cmp_w1[0], cmp_b1[0], cmp_w2[0]), cos_c, sin_c)
    vc = compress_tokens(vcr, cmp_pos[1], cmp_w1[1], cmp_b1[1], cmp_w2[1])
    gates = jax.nn.sigmoid(gc.astype(jnp.float32)).reshape(B, S, N_HEADS, 3)
    gates = gates.transpose(0, 2, 1, 3).astype(x.dtype)
    oc = nsa_attention(apply_rope(to_heads(qc), cos, sin), kc, vc,
                       apply_rope(ksr, cos, sin), vsr, apply_rope(kwr, cos, sin), vwr, gates)
    od = moba_attention(apply_rope(to_heads(qd), cos, sin),
                        apply_rope(to_heads(kd), cos, sin), to_heads(vd))
    mixed = jnp.concatenate([from_heads(oa) * jax.nn.silu(za), from_heads(ob) * jax.nn.silu(zb),
                             from_heads(oc) * jax.nn.silu(zc), from_heads(od) * jax.nn.silu(zd)],
                            axis=-1)
    y = rms_norm(mixed @ w_out, norm_post)
    return x + gate * y


def setup_inputs(seed: int = 0) -> dict:
    key = jax.random.key(seed)
    ks = jax.random.split(key, 12)
    f = jnp.float32
    nrm = jax.random.normal
    x = nrm(ks[0], (BATCH, SEQ, D_MODEL), f)
    c = nrm(ks[1], (BATCH, D_MODEL), f)
    norm_pre = 1.0 + 0.05 * nrm(ks[2], (DEPTH, D_MODEL), f)
    norm_post = 1.0 + 0.05 * nrm(ks[3], (DEPTH, D_MODEL), f)
    w_mod = nrm(ks[4], (DEPTH, D_MODEL, 3 * D_MODEL), f) * (0.5 * D_MODEL ** -0.5)
    b_mod = 0.01 * nrm(ks[5], (DEPTH, 3 * D_MODEL), f)
    w_in = nrm(ks[6], (DEPTH, D_MODEL, N_IN), f) * D_MODEL ** -0.5
    w_out = nrm(ks[7], (DEPTH, MIX_WIDTH, D_MODEL), f) * MIX_WIDTH ** -0.5
    cmp_pos = 0.1 * nrm(ks[8], (DEPTH, 2, CMP_LEN, HEAD_DIM), f)
    cmp_w1 = nrm(ks[9], (DEPTH, 2, CMP_LEN * HEAD_DIM, CMP_HID), f) * (CMP_LEN * HEAD_DIM) ** -0.5
    cmp_b1 = 0.01 * nrm(ks[10], (DEPTH, 2, CMP_HID), f)
    cmp_w2 = nrm(ks[11], (DEPTH, 2, CMP_HID, HEAD_DIM), f) * CMP_HID ** -0.5
    return {'x': x, 'c': c, 'norm_pre': norm_pre, 'norm_post': norm_post,
            'w_mod': w_mod, 'b_mod': b_mod, 'w_in': w_in, 'w_out': w_out,
            'cmp_pos': cmp_pos, 'cmp_w1': cmp_w1, 'cmp_b1': cmp_b1, 'cmp_w2': cmp_w2}


def reference(x, c, norm_pre, norm_post, w_mod, b_mod, w_in, w_out, cmp_pos, cmp_w1, cmp_b1, cmp_w2):
    S = x.shape[1]
    cos, sin = rope_tables(np.arange(S))
    n_cmp = (S - CMP_LEN) // CMP_STRIDE + 1
    cos_c, sin_c = rope_tables(np.arange(n_cmp) * CMP_STRIDE + CMP_LEN - 1)
    for l in range(DEPTH):
        x = hybrid_layer(x, c, norm_pre[l], norm_post[l], w_mod[l], b_mod[l], w_in[l], w_out[l],
                         cmp_pos[l], cmp_w1[l], cmp_b1[l], cmp_w2[l], cos, sin, cos_c, sin_c)
    return x
```

```cpp
#include <hip/hip_runtime.h>
#include <cstdio>
#include <cstdint>
#include <cmath>
namespace pg8 {
#define PG8_LAS __attribute__((address_space(3)))
typedef unsigned short bf16_t;
typedef short bf16x8 __attribute__((ext_vector_type(8)));
typedef float f32x4 __attribute__((ext_vector_type(4)));
typedef unsigned u32x4 __attribute__((ext_vector_type(4)));
constexpr int BM = 256, BK = 64, HALF = 128, HTB = HALF * BK * 2  , STAGE_BYTES = 8 * HTB, NXCD = 8, WGM = 8;

__host__ __device__ __forceinline__ int lds_byte(int r, int c) { const int st = (r >> 4) * 2 + (c >> 5), rr = r & 15, cc = c & 31, ob = rr * 64 + cc * 2; return st * 1024 + (ob ^ (((ob >> 9) & 1) << 5)); }
__host__ __device__ __forceinline__ void stage_rc(int b, int& R, int& C) { const int st = b / 1024, sb = b % 1024, swz = sb ^ (((sb >> 9) & 1) << 5); R = (st >> 1) * 16 + swz / 64; C = (st & 1) * 32 + (swz % 64) / 2; }
__host__ __device__ __forceinline__ int perm32(int rho) { const int n = rho >> 4, i = rho & 15; return 8 * (i >> 2) + 4 * n + (i & 3); }

struct Unit { int pm, pn; };
struct Gemm { const bf16_t* A; const bf16_t* Bt; int M, N, K; };

struct StaticOrder {
    int nM, nN, nwg, G, c;
    __host__ __device__ void init(int M, int N, int G_, int c_) { nM = M / BM; nN = N / BM; nwg = nM * nN; G = G_; c = c_; }
    __host__ __device__ bool next(int i, Unit& u) const {
        const long L = (long)i * G + c; if (L >= nwg) return false;
        int wgid = (int)L; { const int q = nwg / NXCD, r = nwg % NXCD, xcd = wgid % NXCD, off = wgid / NXCD; wgid = (xcd < r ? xcd * (q + 1) : r * (q + 1) + (xcd - r) * q) + off; }
        const int nig = WGM * nN, gid = wgid / nig, fm = gid * WGM, gsz = (nM - fm) < WGM ? (nM - fm) : WGM;
        u.pm = fm + ((wgid % nig) % gsz); u.pn = (wgid % nig) / gsz; return true;
    }
    __device__ __forceinline__ void a_ready(const Unit&) const {}
    __device__ __forceinline__ void done(const Unit&) const {}
};

__device__ __forceinline__ unsigned cvt_pk_bf16(float lo, float hi) { unsigned r; asm volatile("v_cvt_pk_bf16_f32 %0, %1, %2" : "=v"(r) : "v"(lo), "v"(hi)); return r; }
typedef float f32x2 __attribute__((ext_vector_type(2)));
__device__ __forceinline__ f32x2 gelu_pk(f32x2 v) {
    const f32x2 av = __builtin_elementwise_abs(v), d = av * 0.2316418882f + 1.0f;
    f32x2 t; t.x = __builtin_amdgcn_rcpf(d.x); t.y = __builtin_amdgcn_rcpf(d.y);
    f32x2 q = t * 0.5307027145f + (-0.7265760135f); q = q * t + 0.7107068705f; q = q * t + (-0.142248368f); q = q * t + 0.127414796f; q = q * t;
    const f32x2 s = (v * v) * (-0.72134752044f);
    f32x2 e; e.x = __builtin_amdgcn_exp2f(s.x); e.y = __builtin_amdgcn_exp2f(s.y);
    const f32x2 m = v * (q * e), r = v - m;
    f32x2 o; o.x = v.x < 0.f ? m.x : r.x; o.y = v.y < 0.f ? m.y : r.y; return o;
}

template <int ACT  > struct EpiBf16 {
    static constexpr bool PERM = true, AFTER_DRAIN = false; static_assert(ACT == 0 || ACT == 1, "EpiBf16: ACT is 0 (none) or 1 (gelu_pk)");
    bf16_t* O; int ldc; const float* bias; int split_cols; size_t split_stride; float scale0;
    __device__ __forceinline__ void operator()(const f32x4 (&acc)[2][2][4][2], const Unit& u, int wr, int wc, int fr, int fq) const {
        const int row0 = u.pm * BM + wr * 64 + fr; int colt = u.pn * BM; bf16_t* base = O;
        float sc = 1.f; if (split_cols) { const int t = colt / split_cols; base += (size_t)t * split_stride; colt -= t * split_cols; if (t == 0) sc = scale0; }
        const int col0 = colt + wc * 32 + 8 * fq, bcol0 = u.pn * BM + wc * 32 + 8 * fq;
        f32x4 bv[2][2];
#pragma unroll
        for (int bj = 0; bj < 2; ++bj)
#pragma unroll
            for (int n = 0; n < 2; ++n) bv[bj][n] = bias ? *(const f32x4*)(bias + bcol0 + bj * HALF + 4 * n) : (f32x4){0.f, 0.f, 0.f, 0.f};
#pragma unroll
        for (int ai = 0; ai < 2; ++ai)
#pragma unroll
            for (int m = 0; m < 4; ++m) { bf16_t* rowp = base + (size_t)(row0 + ai * HALF + m * 16) * ldc + col0;
#pragma unroll
                for (int bj = 0; bj < 2; ++bj) { f32x4 v0 = acc[ai][bj][m][0] + bv[bj][0], v1 = acc[ai][bj][m][1] + bv[bj][1];
                    if (ACT == 1) { f32x2 a = gelu_pk((f32x2){v0[0], v0[1]}), b = gelu_pk((f32x2){v0[2], v0[3]}), c = gelu_pk((f32x2){v1[0], v1[1]}), d = gelu_pk((f32x2){v1[2], v1[3]});
                        v0 = (f32x4){a.x, a.y, b.x, b.y}; v1 = (f32x4){c.x, c.y, d.x, d.y}; }
                    v0 = v0 * sc; v1 = v1 * sc; u32x4 w; w.x = cvt_pk_bf16(v0[0], v0[1]); w.y = cvt_pk_bf16(v0[2], v0[3]); w.z = cvt_pk_bf16(v1[0], v1[1]); w.w = cvt_pk_bf16(v1[2], v1[3]);
                    *(u32x4*)(rowp + bj * HALF) = w; } }
    }
};
struct EpiProj {
    static constexpr bool PERM = true, AFTER_DRAIN = false;
    bf16_t* O; int ldc; const float* cosT; const float* sinT; float* kmsum;
    __device__ __forceinline__ void operator()(f32x4 (&acc)[2][2][4][2], const Unit& u, int wr, int wc, int fr, int fq) const {
        const int pn = u.pn; const bool tile_all = (pn == 4 || pn == 5 || pn == 8 || pn == 12 || pn == 13);
        const int row0 = u.pm * BM + wr * 64 + fr;
#pragma unroll
        for (int bj = 0; bj < 2; ++bj) {
            const bool roped = ((wc & 1) == 0) && (tile_all || (pn == 9 && bj == 1 && wc == 0) || (pn == 10 && bj == 0 && wc == 0));
            if (roped) {
#pragma unroll
                for (int ai = 0; ai < 2; ++ai)
#pragma unroll
                    for (int m = 0; m < 4; ++m) {
                        const int pos = (row0 + ai * HALF + m * 16) & 4095;
                        f32x4 v0 = acc[ai][bj][m][0], v1 = acc[ai][bj][m][1], p0, p1;
#pragma unroll
                        for (int e = 0; e < 4; ++e) { p0[e] = __shfl_xor(v0[e], 16); p1[e] = __shfl_xor(v1[e], 16); }
                        if (fq < 2) {
                            const f32x4 c0 = *(const f32x4*)(cosT + pos * 8), c1 = *(const f32x4*)(cosT + pos * 8 + 4), s0 = *(const f32x4*)(sinT + pos * 8), s1 = *(const f32x4*)(sinT + pos * 8 + 4);
                            const float sg = (fq == 0) ? -1.f : 1.f;
                            acc[ai][bj][m][0] = v0 * c0 + (p0 * s0) * sg; acc[ai][bj][m][1] = v1 * c1 + (p1 * s1) * sg;
                        }
                    }
            }
        }
        if (pn == 13) {
#pragma unroll
            for (int bj = 0; bj < 2; ++bj)
#pragma unroll
                for (int n = 0; n < 2; ++n) {
                    f32x4 s = (f32x4){0.f, 0.f, 0.f, 0.f};
#pragma unroll
                    for (int ai = 0; ai < 2; ++ai)
#pragma unroll
                        for (int m = 0; m < 4; ++m) s += acc[ai][bj][m][n];
#pragma unroll
                    for (int e = 0; e < 4; ++e) { float v = s[e]; v += __shfl_xor(v, 1); v += __shfl_xor(v, 2); v += __shfl_xor(v, 4); v += __shfl_xor(v, 8); s[e] = v; }
                    if (fr == 0) {
#pragma unroll
                        for (int e = 0; e < 4; ++e) atomicAdd(kmsum + u.pm * 256 + bj * HALF + wc * 32 + 8 * fq + 4 * n + e, s[e]);
                    }
                }
        }
        const int col0 = u.pn * BM + wc * 32 + 8 * fq;
#pragma unroll
        for (int ai = 0; ai < 2; ++ai)
#pragma unroll
            for (int m = 0; m < 4; ++m) { bf16_t* rowp = O + (size_t)(row0 + ai * HALF + m * 16) * ldc + col0;
#pragma unroll
                for (int bj = 0; bj < 2; ++bj) { const f32x4 v0 = acc[ai][bj][m][0], v1 = acc[ai][bj][m][1];
                    u32x4 w; w.x = cvt_pk_bf16(v0[0], v0[1]); w.y = cvt_pk_bf16(v0[2], v0[3]); w.z = cvt_pk_bf16(v1[0], v1[1]); w.w = cvt_pk_bf16(v1[2], v1[3]);
                    *(u32x4*)(rowp + bj * HALF) = w; } }
    }
};
template <class Epi, class Sched, bool ALIGN_EPI = false, bool SP2 = false>
__device__ __forceinline__ void gemm_phase(PG8_LAS unsigned char* lds, const Gemm g, const Sched& S, const Epi& E) {
    const int tid = threadIdx.x, wid = __builtin_amdgcn_readfirstlane(tid >> 6), lane = tid & 63, wr = wid >> 2, wc = wid & 3, fr = lane & 15, fq = lane >> 4;
    const int K = g.K, nt = K / BK;
    unsigned voffA[2], voffB[2];
#pragma unroll
    for (int i = 0; i < 2; ++i) { int R, C; stage_rc(tid * 16 + i * 8192, R, C); const int Rb = Epi::PERM ? ((R & ~31) + perm32(R & 31)) : R;
        voffA[i] = (unsigned)(R * K + C) * 2u; voffB[i] = (unsigned)(Rb * K + C) * 2u; }
    const size_t kstep = (size_t)(BK * 2);
    const size_t hstep = (size_t)HALF * K * 2;
    const size_t tstep = 2 * hstep;
    const unsigned ldsw = (unsigned)wid * 1024u;
    const int aoff = lds_byte(wr * 64 + fr, fq * 8), boff = lds_byte(wc * 32 + fr, fq * 8);
#define PG8_SA(b, h) (((b) * 2 + (h)) * HTB)
#define PG8_SB(b, h) ((4 + (b) * 2 + (h)) * HTB)
#define PG8_STAGE(bufoff, gbase, voff) do { _Pragma("unroll") for (int _i = 0; _i < 2; ++_i) \
        __builtin_amdgcn_global_load_lds((const unsigned*)((const char*)(gbase) + (voff)[_i]), (PG8_LAS unsigned*)(lds + (bufoff) + ldsw + _i * 8192), 16, 0, 0); } while (0)
#define PG8_LDA(dst, b, h) do { _Pragma("unroll") for (int m = 0; m < 4; ++m) _Pragma("unroll") for (int k = 0; k < 2; ++k) dst[m][k] = *(const PG8_LAS bf16x8*)(lds + PG8_SA(b, h) + aoff + m * 2048 + k * 1024); } while (0)
#define PG8_LDB(dst, b, h) do { _Pragma("unroll") for (int n = 0; n < 2; ++n) _Pragma("unroll") for (int k = 0; k < 2; ++k) dst[n][k] = *(const PG8_LAS bf16x8*)(lds + PG8_SB(b, h) + boff + n * 2048 + k * 1024); } while (0)
#define PG8_MMA(ai, bj, At, Bt) do { __builtin_amdgcn_s_setprio(1); _Pragma("unroll") for (int m = 0; m < 4; ++m) _Pragma("unroll") for (int n = 0; n < 2; ++n) _Pragma("unroll") for (int k = 0; k < 2; ++k) \
        acc[ai][bj][m][n] = __builtin_amdgcn_mfma_f32_16x16x32_bf16(Bt[n][k], At[m][k], acc[ai][bj][m][n], 0, 0, 0); __builtin_amdgcn_s_setprio(0); } while (0)
#define PG8_WAIT_V(n) asm volatile("s_waitcnt vmcnt(" #n ")" ::: "memory")
#define PG8_WAIT_L(n) asm volatile("s_waitcnt lgkmcnt(" #n ")" ::: "memory")
#define PG8_BAR __builtin_amdgcn_s_barrier()
#define PG8_SCHED __builtin_amdgcn_sched_barrier(0)
    Unit cur, nxt; int ui = 0;
    if (!S.next(0, cur)) return;
    f32x4 acc[2][2][4][2];
#pragma unroll
    for (int a = 0; a < 2; ++a)
#pragma unroll
        for (int b = 0; b < 2; ++b)
#pragma unroll
            for (int m = 0; m < 4; ++m)
#pragma unroll
                for (int n = 0; n < 2; ++n) acc[a][b][m][n] = (f32x4){0.f, 0.f, 0.f, 0.f};
    bf16x8 At[4][2], B0[2][2], B1[2][2];
    const char* cA = (const char*)g.A + (size_t)cur.pm * tstep; const char* cB = (const char*)g.Bt + (size_t)cur.pn * tstep;
    S.a_ready(cur);
    if constexpr (SP2) {
        PG8_STAGE(PG8_SB(0, 0), cB, voffB); PG8_STAGE(PG8_SB(0, 1), cB + hstep, voffB); PG8_STAGE(PG8_SA(0, 0), cA, voffA); PG8_STAGE(PG8_SA(0, 1), cA + hstep, voffA);
        if (wr == 1) PG8_BAR;
        PG8_WAIT_V(2); PG8_BAR;
        PG8_STAGE(PG8_SB(1, 0), cB + kstep, voffB); PG8_STAGE(PG8_SA(1, 0), cA + kstep, voffA); PG8_STAGE(PG8_SB(1, 1), cB + hstep + kstep, voffB);
        PG8_WAIT_V(6); PG8_BAR;
    } else {
        PG8_STAGE(PG8_SB(0, 0), cB, voffB); PG8_STAGE(PG8_SA(0, 0), cA, voffA); PG8_STAGE(PG8_SB(0, 1), cB + hstep, voffB); PG8_STAGE(PG8_SA(0, 1), cA + hstep, voffA);
        if (wr == 1) PG8_BAR;
        PG8_WAIT_V(4); PG8_BAR;
        PG8_STAGE(PG8_SB(1, 0), cB + kstep, voffB); PG8_STAGE(PG8_SA(1, 0), cA + kstep, voffA); PG8_STAGE(PG8_SB(1, 1), cB + hstep + kstep, voffB);
        PG8_WAIT_V(6); PG8_BAR;
    }
    for (;;) {
        const bool has_next = S.next(ui + 1, nxt);
        const char* nA = has_next ? (const char*)g.A + (size_t)nxt.pm * tstep : cA; const char* nB = has_next ? (const char*)g.Bt + (size_t)nxt.pn * tstep : cB;
        for (int t = 0; t < nt; t += 2) {
            const bool last = (t == nt - 2);
            const char* a1 = cA + (size_t)(t + 1) * kstep;
            const char* a2 = last ? nA : cA + (size_t)(t + 2) * kstep; const char* b2 = last ? nB : cB + (size_t)(t + 2) * kstep;
            const char* a3 = a2 + kstep; const char* b3 = b2 + kstep;
            if (last && has_next) S.a_ready(nxt);
            if constexpr (SP2) {
            PG8_LDB(B0, 0, 0); PG8_LDB(B1, 0, 1); PG8_SCHED; PG8_LDA(At, 0, 0); PG8_STAGE(PG8_SA(1, 1), a1 + hstep, voffA);
            PG8_WAIT_V(8); PG8_WAIT_L(0); PG8_BAR; PG8_MMA(0, 0, At, B0); PG8_MMA(0, 1, At, B1); PG8_BAR; PG8_SCHED;
            PG8_LDA(At, 0, 1); PG8_STAGE(PG8_SB(0, 0), b2, voffB); PG8_STAGE(PG8_SB(0, 1), b2 + hstep, voffB); PG8_STAGE(PG8_SA(0, 0), a2, voffA);
            PG8_WAIT_V(8); PG8_WAIT_L(0); PG8_BAR; PG8_MMA(1, 0, At, B0); PG8_MMA(1, 1, At, B1); PG8_BAR; PG8_SCHED;
            PG8_LDB(B0, 1, 0); PG8_LDB(B1, 1, 1); PG8_SCHED; PG8_LDA(At, 1, 0); PG8_STAGE(PG8_SA(0, 1), a2 + hstep, voffA);
            PG8_WAIT_V(8); PG8_WAIT_L(0); PG8_BAR; PG8_MMA(0, 0, At, B0); PG8_MMA(0, 1, At, B1); PG8_BAR; PG8_SCHED;
            PG8_LDA(At, 1, 1); PG8_STAGE(PG8_SB(1, 0), b3, voffB); PG8_STAGE(PG8_SB(1, 1), b3 + hstep, voffB); PG8_STAGE(PG8_SA(1, 0), a3, voffA);
            PG8_WAIT_V(8); PG8_WAIT_L(0); PG8_BAR; PG8_MMA(1, 0, At, B0); PG8_MMA(1, 1, At, B1); PG8_BAR; PG8_SCHED;
            } else {
            PG8_LDB(B0, 0, 0); PG8_SCHED; PG8_LDA(At, 0, 0); PG8_STAGE(PG8_SA(1, 1), a1 + hstep, voffA);
            PG8_WAIT_L(8); PG8_BAR; PG8_WAIT_L(0); PG8_MMA(0, 0, At, B0); PG8_BAR; PG8_SCHED;
            PG8_LDB(B1, 0, 1); PG8_STAGE(PG8_SB(0, 0), b2, voffB);
            PG8_BAR; PG8_WAIT_L(0); PG8_MMA(0, 1, At, B1); PG8_BAR;
            PG8_LDA(At, 0, 1); PG8_STAGE(PG8_SA(0, 0), a2, voffA);
            PG8_BAR; PG8_WAIT_L(0); PG8_MMA(1, 0, At, B0); PG8_BAR; PG8_SCHED;
            PG8_STAGE(PG8_SB(0, 1), b2 + hstep, voffB);
            PG8_WAIT_V(6); PG8_BAR; PG8_MMA(1, 1, At, B1); PG8_BAR;
            PG8_LDB(B0, 1, 0); PG8_SCHED; PG8_LDA(At, 1, 0); PG8_STAGE(PG8_SA(0, 1), a2 + hstep, voffA);
            PG8_WAIT_L(8); PG8_BAR; PG8_WAIT_L(0); PG8_MMA(0, 0, At, B0); PG8_BAR; PG8_SCHED;
            PG8_LDB(B1, 1, 1); PG8_STAGE(PG8_SB(1, 0), b3, voffB);
            PG8_BAR; PG8_WAIT_L(0); PG8_MMA(0, 1, At, B1); PG8_BAR;
            PG8_LDA(At, 1, 1); PG8_STAGE(PG8_SA(1, 0), a3, voffA);
            PG8_BAR; PG8_WAIT_L(0); PG8_MMA(1, 0, At, B0); PG8_BAR; PG8_SCHED;
            PG8_STAGE(PG8_SB(1, 1), b3 + hstep, voffB);
            PG8_WAIT_V(6); PG8_BAR; PG8_MMA(1, 1, At, B1); PG8_BAR;
            }
        }
        if constexpr (ALIGN_EPI) { if (wr == 0) PG8_BAR; }
        if constexpr (!Epi::AFTER_DRAIN) { E(acc, cur, wr, wc, fr, fq); S.done(cur); }
        if (!has_next) break;
#pragma unroll
        for (int a = 0; a < 2; ++a)
#pragma unroll
            for (int b = 0; b < 2; ++b)
#pragma unroll
                for (int m = 0; m < 4; ++m)
#pragma unroll
                    for (int n = 0; n < 2; ++n) acc[a][b][m][n] = (f32x4){0.f, 0.f, 0.f, 0.f};
        cur = nxt; cA = nA; cB = nB; ++ui;
        if constexpr (ALIGN_EPI) { if (wr == 1) PG8_BAR; }
    }
    PG8_WAIT_V(0);
    if constexpr (!ALIGN_EPI) { if (wr == 0) PG8_BAR; }
    PG8_BAR;
    if constexpr (Epi::AFTER_DRAIN) { E.fused(acc, cur, wr, wc, fr, fq, lds, wid, lane); S.done(cur); }
#undef PG8_SA
#undef PG8_SB
#undef PG8_STAGE
#undef PG8_LDA
#undef PG8_LDB
#undef PG8_MMA
#undef PG8_WAIT_V
#undef PG8_WAIT_L
#undef PG8_BAR
#undef PG8_SCHED
}
}
#define LAS __attribute__((address_space(3)))
#include <hip/hip_runtime.h>
#include <cstdio>
#include <cstdint>
#include <cstdlib>
#include <vector>

#define XB_TMO      128
#define XB_XCNT(j)  (256  + 64 * (j))
#define XB_XSUB(j)  (1280 + 64 * (j))
#define XB_XGEN(j)  (2304 + 64 * (j))
#define XB_TOP      3328
#define XB_TOPGEN   3392
#define XCD_BAR_WORDS 3456
#define XB_SPIN_CAP (1u << 18)

__device__ __forceinline__ unsigned xb_ld(unsigned* p)              { return __hip_atomic_load(p, __ATOMIC_RELAXED, __HIP_MEMORY_SCOPE_AGENT); }
__device__ __forceinline__ unsigned xb_add(unsigned* p, unsigned v) { return __hip_atomic_fetch_add(p, v, __ATOMIC_RELAXED, __HIP_MEMORY_SCOPE_AGENT); }
__device__ __forceinline__ unsigned xb_xcc_id() { return (unsigned)__builtin_amdgcn_s_getreg((3 << 11) | 20) & 0xFu; }
#define XB_SPIN(cond, bar) do { unsigned _sp = 0; while (cond) { __builtin_amdgcn_s_sleep(1); \
    if ((++_sp & 255u) == 0u) { if (xb_ld(&(bar)[XB_TMO])) break; if (_sp > XB_SPIN_CAP) { atomicAdd(&(bar)[XB_TMO], 1u); break; } } } } while (0)

struct XcdBarrier {
    unsigned* bar; unsigned x;
    volatile LAS unsigned* st;
};

__device__ __forceinline__ XcdBarrier xcd_barrier_post(unsigned* bar, volatile LAS unsigned* st) {
    XcdBarrier b; b.bar = bar; b.x = xb_xcc_id(); b.st = st;
    if (threadIdx.x == 0) (void)xb_add(&bar[XB_XCNT(b.x)], 1u);
    return b;
}
__device__ __forceinline__ void xcd_barrier_complete(unsigned* bar, unsigned x, unsigned& nloc, unsigned& nx) {
    const unsigned G = gridDim.x * gridDim.y * gridDim.z;
    unsigned sum, cnt, mine, sp = 0u;
    for (;;) {
        sum = 0u; cnt = 0u; mine = 0u;
#pragma unroll
        for (unsigned j = 0; j < 16; ++j) { const unsigned c = xb_ld(&bar[XB_XCNT(j)]); sum += c; cnt += (c > 0u) ? 1u : 0u; mine = (j == x) ? c : mine; }
        if (sum == G) break;
        __builtin_amdgcn_s_sleep(1);
        if ((++sp & 255u) == 0u) { if (xb_ld(&bar[XB_TMO])) break; if (sp > XB_SPIN_CAP) { atomicAdd(&bar[XB_TMO], 1u); break; } }
    }
    nloc = mine > 0u ? mine : 1u; nx = cnt > 0u ? cnt : 1u;
}

__device__ __forceinline__ void xcd_barrier(const XcdBarrier& b) {
    asm volatile("s_waitcnt vmcnt(0)" ::: "memory");
    __syncthreads();
    if (threadIdx.x == 0) {
        unsigned* bar = b.bar;
        __builtin_amdgcn_s_waitcnt(0);
        unsigned nloc = b.st[0], nx = b.st[1];
        if (nloc == 0u) { xcd_barrier_complete(bar, b.x, nloc, nx); b.st[0] = nloc; b.st[1] = nx; }
        const unsigned old = xb_add(&bar[XB_XSUB(b.x)], 1u);
        const unsigned gen = old / nloc;
        if (old + 1u == (gen + 1u) * nloc) {
            __builtin_amdgcn_fence(__ATOMIC_RELEASE, "agent");
            asm volatile("s_waitcnt vmcnt(0)" ::: "memory");
            const unsigned og = xb_add(&bar[XB_TOP], 1u);
            const unsigned tg = og / nx;
            if (og + 1u == (tg + 1u) * nx) xb_add(&bar[XB_TOPGEN], 1u);
            else XB_SPIN(xb_ld(&bar[XB_TOPGEN]) == tg, bar);
            __builtin_amdgcn_fence(__ATOMIC_ACQUIRE, "agent");
            xb_add(&bar[XB_XGEN(b.x)], 1u);
            asm volatile("s_waitcnt vmcnt(0)" ::: "memory");
        } else {
            XB_SPIN(xb_ld(&bar[XB_XGEN(b.x)]) == gen, bar);
            __builtin_amdgcn_fence(__ATOMIC_ACQUIRE, "agent");
            asm volatile("s_waitcnt vmcnt(0)" ::: "memory");
        }
    }
    __syncthreads();
}
#undef LAS
#ifndef PG8_SP2
#define PG8_SP2 true
#endif
#ifndef PG8_ALIGN
#define PG8_ALIGN true
#endif
#define GAS __attribute__((address_space(1)))
#define LAS __attribute__((address_space(3)))
typedef unsigned short bf16;
typedef unsigned v4u __attribute__((ext_vector_type(4)));
typedef unsigned v2u __attribute__((ext_vector_type(2)));
typedef float f32x4 __attribute__((ext_vector_type(4)));
#define UNR _Pragma("unroll")

constexpr int NWAVES = 8, NTHR = 512;
constexpr int DM = 1024, NB = 4, SEQ = 4096, MROWS = NB * SEQ, DEPTH = 2, NIN = 3980, NP = 4096;
constexpr int PC_QA = 0, PC_KA = 256, PC_VA = 512, PC_ZA = 768, PC_QB = 1024, PC_KB = 1280, PC_VB = 1536, PC_ZB = 1792,
              PC_QC = 2048, PC_KCR = 2304, PC_VCR = 2368, PC_KSR = 2432, PC_VSR = 2496, PC_KWR = 2560, PC_VWR = 2624, PC_GC = 2688, PC_ZC = 2816,
              PC_QD = 3072, PC_KD = 3328, PC_VD = 3584, PC_ZD = 3840;
__host__ __device__ __forceinline__ int src_col(int n) { return n < 2700 ? n : (n < 2816 ? -1 : n - 116); }
constexpr float NEGF = -1e30f;

constexpr size_t MiB = 1u << 20;
constexpr size_t WS_CTL = 0, CTL_BYTES = 1 * MiB;
constexpr int CW_BAR = 4096;
constexpr int CW_Q = 8192;
constexpr size_t WS_KMSUM = 512 * 1024;
constexpr size_t WS_MOD = 1 * MiB;
constexpr size_t WS_COS = WS_MOD + 128 * 1024, WS_SIN = WS_COS + 128 * 1024, WS_COSC = WS_SIN + 128 * 1024, WS_SINC = WS_COSC + 8192;
constexpr size_t WS_SELM = WS_SINC + 8192;
constexpr size_t WS_KCF = 2 * MiB;
constexpr size_t WS_VCF = WS_KCF + 256 * 1024;
constexpr size_t WS_KCB = 2 * MiB + 512 * 1024, WS_VCB = WS_KCB + 128 * 1024;
constexpr size_t WS_POSP = 2 * MiB + 768 * 1024;
constexpr size_t WS_W2T = 2 * MiB + 896 * 1024;
constexpr size_t WS_W1T = 4 * MiB;
constexpr size_t WS_HID = 60 * MiB;
constexpr size_t WS_WIN = 8 * MiB;
constexpr size_t WS_WOUT = 24 * MiB;
constexpr size_t WS_XN = 28 * MiB;
constexpr size_t WS_Y = 60 * MiB;
constexpr size_t WS_PCN = WS_XN;
constexpr size_t WS_BO = WS_XN;
constexpr size_t WS_BL = 54 * MiB;
constexpr size_t WS_MIXED = 92 * MiB;
constexpr size_t WS_PROJ = 124 * MiB;
constexpr size_t WS_END = 252 * MiB;

constexpr int RING_BYTES = 131072, MISC_OFF = RING_BYTES + 320, LDS_BYTES = 147456;

#define LDS_WAIT() asm volatile("s_waitcnt lgkmcnt(0)" ::: "memory")
#define VM_WAIT() asm volatile("s_waitcnt vmcnt(0)" ::: "memory")
__device__ __forceinline__ unsigned f2bf(float f) { unsigned u = __builtin_bit_cast(unsigned, f); return (u + 0x7fffu + ((u >> 16) & 1u)) >> 16; }
__device__ __forceinline__ unsigned pk2(float lo, float hi) { return f2bf(lo) | (f2bf(hi) << 16); }
__device__ __forceinline__ float bflo(unsigned u) { return __uint_as_float(u << 16); }
__device__ __forceinline__ float bfhi(unsigned u) { return __uint_as_float(u & 0xffff0000u); }
__device__ __forceinline__ float bf1(bf16 v) { return __uint_as_float((unsigned)v << 16); }
__device__ __forceinline__ float lsig(float x) { return fminf(x, 0.f) - log1pf(expf(-fabsf(x))); }
__device__ __forceinline__ float siluf(float x) { return x / (1.f + expf(-x)); }
__device__ __forceinline__ float sigmf(float x) { return 1.f / (1.f + expf(-x)); }
__device__ __forceinline__ float gelu_tanh(float x) { return 0.5f * x * (1.f + tanhf(0.7978845608028654f * (x + 0.044715f * x * x * x))); }
__device__ __forceinline__ float wave_sum(float v) { UNR for (int o = 1; o < 64; o <<= 1) v += __shfl_xor(v, o); return v; }

struct Frame { LAS unsigned char* lds; int tid, lane, wave, vcu, G; unsigned char* ws; };

template <class SRC> __device__ __forceinline__ void p0_transpose_item(const float* W, int K, int Nsrc, bf16* WT, LAS float* scr, int kb, int n0, int lane, SRC src) {
    const int k0 = 64 * kb; const int sc = src(n0 + (lane & 31));
    UNR for (int i = 0; i < 32; ++i) { const int kk = 2 * i + (lane >> 5); scr[kk * 33 + (lane & 31)] = (sc >= 0) ? W[(size_t)(k0 + kk) * Nsrc + sc] : 0.f; }
    LDS_WAIT(); asm volatile("" ::: "memory");
    const int c = lane & 7;
    UNR for (int j = 0; j < 4; ++j) { const int n = (lane >> 3) + 8 * j; const LAS float* s = scr + (8 * c) * 33 + n;
        v4u o; o.x = pk2(s[0 * 33], s[1 * 33]); o.y = pk2(s[2 * 33], s[3 * 33]); o.z = pk2(s[4 * 33], s[5 * 33]); o.w = pk2(s[6 * 33], s[7 * 33]);
        *(v4u*)(WT + (size_t)(n0 + n) * K + k0 + 8 * c) = o; }
    LDS_WAIT(); asm volatile("" ::: "memory");
}
struct SrcWin { __device__ __forceinline__ int operator()(int n) const { return src_col(n); } };
struct SrcId { __device__ __forceinline__ int operator()(int n) const { return n; } };

__device__ __forceinline__ void p0_prologue(Frame& F, const float* w_in, const float* w_out, const float* cvec, const float* w_mod, const float* b_mod, const float* cmp_pos, const float* cmp_w1, const float* cmp_w2, const float (&rf)[8]) {
    LAS float* scr = (LAS float*)(F.lds + F.wave * 16384);
    const int gw = F.vcu * NWAVES + F.wave, NGW = F.G * NWAVES;
    constexpr int I_IN = (DM / 64) * (NP / 32), I_OUT = (DM / 64) * (DM / 32), I_W1 = 2 * (2048 / 64) * (256 / 32), I_W2 = 2 * (256 / 64) * (64 / 32), I_L = I_IN + I_OUT + I_W1 + I_W2, NITEMS = DEPTH * I_L;
    for (int it = gw; it < NITEMS; it += NGW) {
        int r = it; const int l = r / I_L; r -= l * I_L;
        if (r >= I_IN + I_OUT) { r -= I_IN + I_OUT;
            if (r < I_W1) { const int kv = r / (I_W1 / 2), rr = r % (I_W1 / 2), nblk = 256 / 32;
                p0_transpose_item(cmp_w1 + (size_t)(l * 2 + kv) * 2048 * 256, 2048, 256, (bf16*)(F.ws + WS_W1T) + (size_t)(l * 2 + kv) * 256 * 2048, scr, rr / nblk, 32 * (rr % nblk), F.lane, SrcId()); }
            else { r -= I_W1; const int kv = r / (I_W2 / 2), rr = r % (I_W2 / 2), nblk = 64 / 32;
                p0_transpose_item(cmp_w2 + (size_t)(l * 2 + kv) * 256 * 64, 256, 64, (bf16*)(F.ws + WS_W2T) + (size_t)(l * 2 + kv) * 64 * 256, scr, rr / nblk, 32 * (rr % nblk), F.lane, SrcId()); }
            continue; }
        if (r < I_IN) { const int nblk = NP / 32; p0_transpose_item(w_in + (size_t)l * DM * NIN, DM, NIN, (bf16*)(F.ws + WS_WIN) + (size_t)l * NP * DM, scr, r / nblk, 32 * (r % nblk), F.lane, SrcWin()); }
        else { r -= I_IN; const int nblk = DM / 32; p0_transpose_item(w_out + (size_t)l * DM * DM, DM, DM, (bf16*)(F.ws + WS_WOUT) + (size_t)l * DM * DM, scr, r / nblk, 32 * (r % nblk), F.lane, SrcId()); }
    }
    for (int it = gw; it < DEPTH * 2 * 16 * 4; it += NGW) { const int ug = it & 3, c = (it >> 2) & 15, lk = it >> 6, u = 64 * ug + F.lane;
        const float* pos = cmp_pos + (size_t)lk * 2048 + 128 * c; const float* w = cmp_w1 + ((size_t)lk * 2048 + 128 * c) * 256 + u; float s = 0.f;
        for (int i = 0; i < 128; ++i) s += pos[i] * w[(size_t)i * 256];
        ((float*)(F.ws + WS_POSP))[((size_t)lk * 16 + c) * 256 + u] = s; }
    { float* cosT = (float*)(F.ws + WS_COS); float* sinT = (float*)(F.ws + WS_SIN); float* cosC = (float*)(F.ws + WS_COSC); float* sinC = (float*)(F.ws + WS_SINC);
      for (int idx = blockIdx.x * NTHR + F.tid; idx < SEQ * 8 + 255 * 8; idx += F.G * NTHR) {
          if (idx < SEQ * 8) { const int pos = idx / 8, i = idx % 8; const float ang = (float)pos * rf[i]; cosT[idx] = cosf(ang); sinT[idx] = sinf(ang); }
          else { const int j = idx - SEQ * 8, n = j / 8, i = j % 8; const float ang = (float)(n * 16 + 31) * rf[i]; cosC[j] = cosf(ang); sinC[j] = sinf(ang); } } }
    __syncthreads();
    { LAS float* sc = (LAS float*)F.lds; LAS float* red = sc + NB * DM;
      for (int i = F.tid; i < NB * DM; i += NTHR) sc[i] = siluf(cvec[i]);
      __syncthreads();
      float* mod = (float*)(F.ws + WS_MOD);
      for (int cg = blockIdx.x; cg < DEPTH * 3072 / 24; cg += F.G) {
          const int kg = F.tid >> 5, cs = F.tid & 31;
          if (cs < 24) { const int gn = cg * 24 + cs, l = gn / 3072, n = gn % 3072; const float* w = w_mod + (size_t)l * DM * 3072 + n;
              float a0 = 0.f, a1 = 0.f, a2 = 0.f, a3 = 0.f;
              for (int k = kg * 64; k < kg * 64 + 64; ++k) { const float wv = w[(size_t)k * 3072]; a0 += sc[k] * wv; a1 += sc[DM + k] * wv; a2 += sc[2 * DM + k] * wv; a3 += sc[3 * DM + k] * wv; }
              LAS float* r4 = red + (kg * 24 + cs) * 4; r4[0] = a0; r4[1] = a1; r4[2] = a2; r4[3] = a3; }
          __syncthreads();
          if (F.tid < 96) { const int cs2 = F.tid >> 2, b = F.tid & 3; float s = 0.f; UNR for (int g = 0; g < 16; ++g) s += red[(g * 24 + cs2) * 4 + b];
              const int gn = cg * 24 + cs2, l = gn / 3072, n = gn % 3072; mod[(l * NB + b) * 3072 + n] = s + b_mod[l * 3072 + n]; }
          __syncthreads();
      } }
}
__device__ __forceinline__ void xn_rows(Frame& F, const float* x, const float* g, const float* mod_l, bf16* XN) {
    const int gw = F.vcu * NWAVES + F.wave, NGW = F.G * NWAVES;
    for (int m = gw; m < MROWS; m += NGW) {
        const f32x4* xr = (const f32x4*)(x + (size_t)m * DM) + F.lane; const float* mb = mod_l + (m / SEQ) * 3072;
        f32x4 v[4]; float s = 0.f;
        UNR for (int j = 0; j < 4; ++j) { v[j] = xr[64 * j]; s += (v[j].x * v[j].x + v[j].y * v[j].y) + (v[j].z * v[j].z + v[j].w * v[j].w); }
        const float r = rsqrtf(wave_sum(s) * (1.f / DM) + 1e-6f);
        unsigned long long* o8 = (unsigned long long*)(XN + (size_t)m * DM) + F.lane;
        UNR for (int j = 0; j < 4; ++j) { const int c0 = 4 * (64 * j + F.lane); const f32x4 gg = *(const f32x4*)(g + c0), sh = *(const f32x4*)(mb + c0), scl = *(const f32x4*)(mb + 1024 + c0);
            const f32x4 o = (v[j] * r * gg) * (scl + 1.f) + sh;
            o8[64 * j] = (unsigned long long)pk2(o.x, o.y) | ((unsigned long long)pk2(o.z, o.w) << 32); }
    }
}
__device__ __forceinline__ void final_rows(Frame& F, const bf16* Y, const float* xin, const float* gpost, const float* mod_l, float* out, bool do_next, const float* gpre_n, const float* mod_n, bf16* XN) {
    const int gw = F.vcu * NWAVES + F.wave, NGW = F.G * NWAVES;
    for (int m = gw; m < MROWS; m += NGW) {
        const float* mb = mod_l + (m / SEQ) * 3072 + 2048;
        float yv[16]; float s = 0.f;
        UNR for (int j = 0; j < 2; ++j) { const v4u w = *((const v4u*)(Y + (size_t)m * DM) + 64 * j + F.lane);
            yv[8 * j + 0] = bflo(w.x); yv[8 * j + 1] = bfhi(w.x); yv[8 * j + 2] = bflo(w.y); yv[8 * j + 3] = bfhi(w.y); yv[8 * j + 4] = bflo(w.z); yv[8 * j + 5] = bfhi(w.z); yv[8 * j + 6] = bflo(w.w); yv[8 * j + 7] = bfhi(w.w); }
        UNR for (int i = 0; i < 16; ++i) s += yv[i] * yv[i];
        const float r = rsqrtf(wave_sum(s) * (1.f / DM) + 1e-6f);
        float xo[16]; float s2 = 0.f;
        UNR for (int j = 0; j < 2; ++j) { const int c0 = 8 * (64 * j + F.lane);
            UNR for (int h = 0; h < 2; ++h) { const f32x4 xv = *(const f32x4*)(xin + (size_t)m * DM + c0 + 4 * h), gp = *(const f32x4*)(gpost + c0 + 4 * h), gt = *(const f32x4*)(mb + c0 + 4 * h);
                f32x4 o; UNR for (int e = 0; e < 4; ++e) { o[e] = xv[e] + gt[e] * (yv[8 * j + 4 * h + e] * r * gp[e]); xo[8 * j + 4 * h + e] = o[e]; s2 += o[e] * o[e]; }
                *(f32x4*)(out + (size_t)m * DM + c0 + 4 * h) = o; } }
        if (do_next) {
            const float r2 = rsqrtf(wave_sum(s2) * (1.f / DM) + 1e-6f); const float* mn = mod_n + (m / SEQ) * 3072;
            UNR for (int j = 0; j < 2; ++j) { const int c0 = 8 * (64 * j + F.lane); float o[8];
                UNR for (int e = 0; e < 8; ++e) o[e] = (xo[8 * j + e] * r2 * gpre_n[c0 + e]) * (1.f + mn[1024 + c0 + e]) + mn[c0 + e];
                v4u w; w.x = pk2(o[0], o[1]); w.y = pk2(o[2], o[3]); w.z = pk2(o[4], o[5]); w.w = pk2(o[6], o[7]);
                *((v4u*)(XN + (size_t)m * DM) + 64 * j + F.lane) = w; }
        }
    }
}
__device__ __forceinline__ void ld64(const bf16* p, float (&d)[64]) {
    UNR for (int i = 0; i < 8; ++i) { const v4u w = *(const v4u*)(p + 8 * i);
        d[8 * i + 0] = bflo(w.x); d[8 * i + 1] = bfhi(w.x); d[8 * i + 2] = bflo(w.y); d[8 * i + 3] = bfhi(w.y); d[8 * i + 4] = bflo(w.z); d[8 * i + 5] = bfhi(w.z); d[8 * i + 6] = bflo(w.w); d[8 * i + 7] = bfhi(w.w); }
}
__device__ __forceinline__ float dot64(const float (&q)[64], const bf16* p) {
    float s = 0.f;
    UNR for (int i = 0; i < 8; ++i) { const v4u w = *(const v4u*)(p + 8 * i);
        s += q[8 * i + 0] * bflo(w.x) + q[8 * i + 1] * bfhi(w.x) + q[8 * i + 2] * bflo(w.y) + q[8 * i + 3] * bfhi(w.y) + q[8 * i + 4] * bflo(w.z) + q[8 * i + 5] * bfhi(w.z) + q[8 * i + 6] * bflo(w.w) + q[8 * i + 7] * bfhi(w.w); }
    return s;
}
__device__ __forceinline__ void axpy64(float (&o)[64], float a, const bf16* p) {
    UNR for (int i = 0; i < 8; ++i) { const v4u w = *(const v4u*)(p + 8 * i);
        o[8 * i + 0] += a * bflo(w.x); o[8 * i + 1] += a * bfhi(w.x); o[8 * i + 2] += a * bflo(w.y); o[8 * i + 3] += a * bfhi(w.y); o[8 * i + 4] += a * bflo(w.z); o[8 * i + 5] += a * bfhi(w.z); o[8 * i + 6] += a * bflo(w.w); o[8 * i + 7] += a * bfhi(w.w); }
}
__device__ __forceinline__ void scal_axpy64(float (&o)[64], float al, float a, const bf16* p) {
    UNR for (int i = 0; i < 8; ++i) { const v4u w = *(const v4u*)(p + 8 * i);
        o[8 * i + 0] = o[8 * i + 0] * al + a * bflo(w.x); o[8 * i + 1] = o[8 * i + 1] * al + a * bfhi(w.x); o[8 * i + 2] = o[8 * i + 2] * al + a * bflo(w.y); o[8 * i + 3] = o[8 * i + 3] * al + a * bfhi(w.y);
        o[8 * i + 4] = o[8 * i + 4] * al + a * bflo(w.z); o[8 * i + 5] = o[8 * i + 5] * al + a * bfhi(w.z); o[8 * i + 6] = o[8 * i + 6] * al + a * bflo(w.w); o[8 * i + 7] = o[8 * i + 7] * al + a * bfhi(w.w); }
}
__device__ __forceinline__ void store_gated(bf16* mx, const float (&o)[64], float sc, const bf16* zp) {
    UNR for (int i = 0; i < 8; ++i) { const v4u z = *(const v4u*)(zp + 8 * i); v4u w;
        w.x = pk2(o[8 * i + 0] * sc * siluf(bflo(z.x)), o[8 * i + 1] * sc * siluf(bfhi(z.x))); w.y = pk2(o[8 * i + 2] * sc * siluf(bflo(z.y)), o[8 * i + 3] * sc * siluf(bfhi(z.y)));
        w.z = pk2(o[8 * i + 4] * sc * siluf(bflo(z.z)), o[8 * i + 5] * sc * siluf(bfhi(z.z))); w.w = pk2(o[8 * i + 6] * sc * siluf(bflo(z.w)), o[8 * i + 7] * sc * siluf(bfhi(z.w)));
        *(v4u*)(mx + 8 * i) = w; }
}
#define ONLINE(sc_, vp_) do { const float mn_ = fmaxf(m, (sc_)), al_ = expf(m - mn_), p_ = expf((sc_) - mn_); l = l * al_ + p_; m = mn_; scal_axpy64(o, al_, p_, (vp_)); } while (0)

__device__ __forceinline__ void nv_A(const bf16* P, bf16* MX, int h, int t0, int t) {
    float q[64], o[64];
    ld64(P + (size_t)t * NP + PC_QA + h * 64, q); UNR for (int d = 0; d < 64; ++d) { q[d] *= 0.125f; o[d] = 0.f; }
    float carry = 0.f;
    _Pragma("unroll 1") for (int s = t0 + 254; s >= 0; --s) {
        const float z = dot64(q, P + (size_t)s * NP + PC_KA + h * 64);
        if (s < t) { const float a = expf(lsig(z) + carry); axpy64(o, a, P + (size_t)s * NP + PC_VA + h * 64); carry += lsig(-z); }
    }
    store_gated(MX + (size_t)t * DM + 0 + h * 64, o, 1.f, P + (size_t)t * NP + PC_ZA + h * 64);
}
__device__ __forceinline__ void nv_B(const bf16* P, bf16* MX, int h, int t) {
    float q[64], o[64];
    ld64(P + (size_t)t * NP + PC_QB + h * 64, q); UNR for (int d = 0; d < 64; ++d) { q[d] *= 0.125f; o[d] = 0.f; }
    float m = -INFINITY, l = 0.f;
    _Pragma("unroll 1") for (int c = 0; c < 3; ++c) { const int dil = (c == 0) ? 1 : (c == 1 ? 4 : 16);
        _Pragma("unroll 1") for (int n = 0; n <= 128; ++n) { const int idx = t - dil * n;
            if (idx >= 0) { const float sc = dot64(q, P + (size_t)idx * NP + PC_KB + h * 64); ONLINE(sc, P + (size_t)idx * NP + PC_VB + h * 64); } } }
    store_gated(MX + (size_t)t * DM + 256 + h * 64, o, 1.f / l, P + (size_t)t * NP + PC_ZB + h * 64);
}
__device__ __forceinline__ void nv_D(const bf16* P, const float* kms  , bf16* MX, int h, int t0, int t) {
    const int own = t0 >> 8;
    float q[64], o[64];
    ld64(P + (size_t)t * NP + PC_QD + h * 64, q); UNR for (int d = 0; d < 64; ++d) o[d] = 0.f;
    float g[16];
    UNR for (int n = 0; n < 16; ++n) { const float* kp = kms + n * 256 + h * 64; float s = 0.f; UNR for (int d = 0; d < 64; ++d) s += q[d] * (kp[d] * (1.f / 256.f)); g[n] = (n < own) ? s : NEGF; }
    unsigned selbits = 0u;
    UNR for (int r = 0; r < 3; ++r) { float best = -INFINITY; int bi = 0;
        UNR for (int n = 0; n < 16; ++n) { if (!((selbits >> n) & 1u) && g[n] > best) { best = g[n]; bi = n; } }
        selbits |= 1u << bi; }
    UNR for (int d = 0; d < 64; ++d) q[d] *= 0.125f;
    float m = -INFINITY, l = 0.f;
    _Pragma("unroll 1") for (int n = 0; n <= own; ++n)
        _Pragma("unroll 1") for (int j = 0; j < 256; ++j) { const int kpos = n * 256 + j;
            const float sc = dot64(q, P + (size_t)kpos * NP + PC_KD + h * 64);
            const bool use = (n == own) ? (kpos <= t) : (((selbits >> n) & 1u) != 0u);
            if (use) ONLINE(sc, P + (size_t)kpos * NP + PC_VD + h * 64); }
    store_gated(MX + (size_t)t * DM + 768 + h * 64, o, 1.f / l, P + (size_t)t * NP + PC_ZD + h * 64);
}
__device__ __forceinline__ void nv_C1(const bf16* P, const float* kc, float* pcb  , int h, int t) {
    float q[64]; ld64(P + (size_t)t * NP + PC_QC + h * 64, q); UNR for (int d = 0; d < 64; ++d) q[d] *= 0.125f;
    float* pr = pcb + ((size_t)h * SEQ + t) * 256; float m = -INFINITY;
    _Pragma("unroll 1") for (int n = 0; n < 255; ++n) { const float* kp = kc + n * 64; float s = 0.f; UNR for (int d = 0; d < 64; ++d) s += q[d] * kp[d]; pr[n] = s; if ((16 * n + 31) <= t) m = fmaxf(m, s); }
    float l = 0.f;
    _Pragma("unroll 1") for (int n = 0; n < 255; ++n) if ((16 * n + 31) <= t) l += expf(pr[n] - m);
    const float il = (l > 0.f) ? 1.f / l : 0.f;
    _Pragma("unroll 1") for (int n = 0; n < 255; ++n) pr[n] = ((16 * n + 31) <= t) ? expf(pr[n] - m) * il : 0.f;
}
template <int ST> __device__ __forceinline__ void nv_C2(const float* pcb, unsigned long long* selm, LAS float* imp, int t) {
    _Pragma("unroll 1") for (int s = 0; s < 64; ++s) imp[s * ST] = 0.f;
    _Pragma("unroll 1") for (int n = 0; n < 255; ++n) { float p = 0.f; for (int h = 0; h < 4; ++h) p += pcb[((size_t)h * SEQ + t) * 256 + n];
        const int s0 = n >> 2; if ((n & 3) != 3) imp[s0 * ST] += p; else { imp[s0 * ST] += 0.5f * p; imp[(s0 + 1) * ST] += 0.5f * p; } }
    const int own = t >> 6;
    _Pragma("unroll 1") for (int s = 0; s < 64; ++s) { float v = imp[s * ST]; const bool valid = s <= own, forced = (s == 0) || (s >= own - 1); imp[s * ST] = valid ? (forced ? 1e9f : v) : NEGF; }
    unsigned long long mask = 0ull;
    _Pragma("unroll 1") for (int r = 0; r < 16; ++r) { float best = -INFINITY; int bi = 0;
        _Pragma("unroll 1") for (int s = 0; s < 64; ++s) { const float v = imp[s * ST]; if (v > best) { best = v; bi = s; } }
        mask |= 1ull << bi; imp[bi * ST] = -INFINITY; }
    selm[t] = mask;
}
template <int ST> __device__ __forceinline__ void nv_C3(const bf16* P, const float* pcb, const float* vc, const unsigned long long* selm, bf16* MX, LAS float* res, int h, int t0, int t) {
    float q[64], o[64];
    ld64(P + (size_t)t * NP + PC_QC + h * 64, q); UNR for (int d = 0; d < 64; ++d) { q[d] *= 0.125f; o[d] = 0.f; }
    const float g0 = sigmf(bf1(P[(size_t)t * NP + PC_GC + h * 3 + 0])), g1 = sigmf(bf1(P[(size_t)t * NP + PC_GC + h * 3 + 1])), g2 = sigmf(bf1(P[(size_t)t * NP + PC_GC + h * 3 + 2]));
    { const float* pr = pcb + ((size_t)h * SEQ + t) * 256;
      _Pragma("unroll 1") for (int n = 0; n < 255; ++n) { const float p = pr[n]; const float* vp = vc + n * 64; UNR for (int d = 0; d < 64; ++d) o[d] += p * vp[d]; }
      UNR for (int d = 0; d < 64; ++d) { res[d * ST] = g0 * o[d]; o[d] = 0.f; } }
    const unsigned long long mask = selm[t];
    float m = -INFINITY, l = 0.f;
    const int smax = (t0 + 255) >> 6;
    _Pragma("unroll 1") for (int s = 0; s <= smax; ++s)
        _Pragma("unroll 1") for (int j = 0; j < 64; ++j) { const int kpos = s * 64 + j;
            const float sc = dot64(q, P + (size_t)kpos * NP + PC_KSR);
            if (((mask >> s) & 1ull) && kpos <= t) ONLINE(sc, P + (size_t)kpos * NP + PC_VSR); }
    { const float il = g1 / l; UNR for (int d = 0; d < 64; ++d) { res[d * ST] += o[d] * il; o[d] = 0.f; } }
    m = -INFINITY; l = 0.f;
    int klo = t0 - 511; if (klo < 0) klo = 0;
    _Pragma("unroll 1") for (int kpos = klo; kpos <= t0 + 255; ++kpos) { const float sc = dot64(q, P + (size_t)kpos * NP + PC_KWR); const int dist = t - kpos;
        if (dist >= 0 && dist < 512) ONLINE(sc, P + (size_t)kpos * NP + PC_VWR); }
    { const float il = g2 / l; UNR for (int d = 0; d < 64; ++d) o[d] = res[d * ST] + o[d] * il; }
    store_gated(MX + (size_t)t * DM + 512 + h * 64, o, 1.f, P + (size_t)t * NP + PC_ZC + h * 64);
}
namespace att {
typedef short bf16x8 __attribute__((ext_vector_type(8)));
typedef short s16x4 __attribute__((ext_vector_type(4)));
typedef float f32x16 __attribute__((ext_vector_type(16)));
typedef __attribute__((address_space(3))) const unsigned char* lptr;
constexpr float LOG2E = 1.4426950408889634f, C2 = 0.125f * LOG2E;
constexpr int SLOT = 16384;
__device__ __forceinline__ int crow(int r, int hi) { return (r & 3) + 8 * (r >> 2) + 4 * hi; }
__device__ __forceinline__ float swapmax(float v) { auto rr = __builtin_amdgcn_permlane32_swap(__float_as_uint(v), __float_as_uint(v), false, false); return fmaxf(__uint_as_float(rr[0]), __uint_as_float(rr[1])); }
__device__ __forceinline__ float swapsum(float v) { auto rr = __builtin_amdgcn_permlane32_swap(__float_as_uint(v), __float_as_uint(v), false, false); return __uint_as_float(rr[0]) + __uint_as_float(rr[1]); }
__device__ __forceinline__ float swapoth(float v) { auto rr = __builtin_amdgcn_permlane32_swap(__float_as_uint(v), __float_as_uint(v), false, false); return (threadIdx.x & 32) ? __uint_as_float(rr[0]) : __uint_as_float(rr[1]); }
typedef float f32x2_t __attribute__((ext_vector_type(2))); typedef __bf16 bf16x2_t __attribute__((ext_vector_type(2)));
__device__ __forceinline__ unsigned cvtpk(float lo, float hi) { f32x2_t v = {lo, hi}; bf16x2_t b = __builtin_convertvector(v, bf16x2_t); return __builtin_bit_cast(unsigned, b); }
typedef short v4i16_t __attribute__((ext_vector_type(4)));
__device__ __forceinline__ s16x4 vtr(lptr p) { return __builtin_bit_cast(s16x4, __builtin_amdgcn_ds_read_tr16_b64_v4i16((__attribute__((address_space(3))) v4i16_t*)p)); }

__device__ __forceinline__ void stage(const bf16* kp, const bf16* vp, LAS unsigned char* slot, int wave) {
    __builtin_amdgcn_global_load_lds((const unsigned*)kp, (LAS unsigned*)(slot + wave * 1024), 16, 0, 0);
    __builtin_amdgcn_global_load_lds((const unsigned*)vp, (LAS unsigned*)(slot + 8192 + wave * 1024), 16, 0, 0);
}
__device__ __forceinline__ void qk_tile(f32x16& p0, f32x16& p1, lptr kslot, const bf16x8 (&qr)[4], int r32, int hi) {
    const lptr kb = kslot + hi * 1024 + r32 * 16;
    f32x16 z = {0.f, 0.f, 0.f, 0.f, 0.f, 0.f, 0.f, 0.f, 0.f, 0.f, 0.f, 0.f, 0.f, 0.f, 0.f, 0.f};
    p0 = z; p1 = z;
    UNR for (int d0 = 0; d0 < 4; ++d0) {
        const bf16x8 a0 = *(const __attribute__((address_space(3))) bf16x8*)(kb + d0 * 2048);
        const bf16x8 a1 = *(const __attribute__((address_space(3))) bf16x8*)(kb + d0 * 2048 + 512);
        p0 = __builtin_amdgcn_mfma_f32_32x32x16_bf16(a0, qr[d0], p0, 0, 0, 0);
        p1 = __builtin_amdgcn_mfma_f32_32x32x16_bf16(a1, qr[d0], p1, 0, 0, 0);
    }
}
__device__ __forceinline__ void pv_tile(f32x16 (&o)[2], lptr vslot, int lane, const f32x16& p0, const f32x16& p1) {
    const int hi = lane >> 5; const lptr vb = vslot + ((lane >> 4) & 1) * 32 + (lane & 3) * 8 + (4 * hi + ((lane & 15) >> 2)) * 64;
    typedef unsigned u32x4_t __attribute__((ext_vector_type(4)));
    u32x4_t w0 = {cvtpk(p0[0], p0[1]), cvtpk(p0[2], p0[3]), cvtpk(p0[4], p0[5]), cvtpk(p0[6], p0[7])}, w1 = {cvtpk(p0[8], p0[9]), cvtpk(p0[10], p0[11]), cvtpk(p0[12], p0[13]), cvtpk(p0[14], p0[15])};
    u32x4_t w2 = {cvtpk(p1[0], p1[1]), cvtpk(p1[2], p1[3]), cvtpk(p1[4], p1[5]), cvtpk(p1[6], p1[7])}, w3 = {cvtpk(p1[8], p1[9]), cvtpk(p1[10], p1[11]), cvtpk(p1[12], p1[13]), cvtpk(p1[14], p1[15])};
    const bf16x8 pw[4] = {__builtin_bit_cast(bf16x8, w0), __builtin_bit_cast(bf16x8, w1), __builtin_bit_cast(bf16x8, w2), __builtin_bit_cast(bf16x8, w3)};
    UNR for (int dh = 0; dh < 2; ++dh)
        UNR for (int ks = 0; ks < 4; ++ks) {
            const s16x4 lo = vtr(vb + dh * 4096 + ks * 1024), hh = vtr(vb + dh * 4096 + ks * 1024 + 512);
            const bf16x8 vf = {lo[0], lo[1], lo[2], lo[3], hh[0], hh[1], hh[2], hh[3]};
            o[dh] = __builtin_amdgcn_mfma_f32_32x32x16_bf16(vf, pw[ks], o[dh], 0, 0, 0);
        }
}
__device__ __forceinline__ void softmax_step(f32x16& p0, f32x16& p1, float& m, float& l, f32x16 (&o)[2]) {
    float mx = fmaxf(p0[0], p1[0]);
    UNR for (int r = 1; r < 16; ++r) mx = fmaxf(mx, fmaxf(p0[r], p1[r]));
    mx = swapmax(mx);
    const float mn = fmaxf(m, mx), alpha = __builtin_amdgcn_exp2f((m - mn) * C2), nb = -mn * C2;
    float s = 0.f;
    UNR for (int r = 0; r < 16; ++r) { p0[r] = __builtin_amdgcn_exp2f(__builtin_fmaf(p0[r], C2, nb)); p1[r] = __builtin_amdgcn_exp2f(__builtin_fmaf(p1[r], C2, nb)); s += p0[r] + p1[r]; }
    l = l * alpha + s; m = mn;
    if (!__all(alpha == 1.f)) { UNR for (int r = 0; r < 16; ++r) { o[0][r] *= alpha; o[1][r] *= alpha; } }
}
__device__ __forceinline__ void store_gated_T(bf16* mrow, const bf16* zrow, const f32x16 (&o)[2], float scale, int hi) {
    UNR for (int dh = 0; dh < 2; ++dh)
        UNR for (int g = 0; g < 4; ++g) { const int d = 32 * dh + 8 * g + 4 * hi; const v2u z = *(const v2u*)(zrow + d);
            v2u w; w.x = pk2(o[dh][4 * g + 0] * scale * siluf(bflo(z.x)), o[dh][4 * g + 1] * scale * siluf(bfhi(z.x))); w.y = pk2(o[dh][4 * g + 2] * scale * siluf(bflo(z.y)), o[dh][4 * g + 3] * scale * siluf(bfhi(z.y)));
            *(v2u*)(mrow + d) = w; }
}
__device__ __forceinline__ void zero_o(f32x16 (&o)[2]) { UNR for (int r = 0; r < 16; ++r) { o[0][r] = 0.f; o[1][r] = 0.f; } }
__device__ __forceinline__ void load_q(bf16x8 (&qr)[4], const bf16* qrow, int hi) { UNR for (int d0 = 0; d0 < 4; ++d0) qr[d0] = *(const bf16x8*)(qrow + d0 * 16 + hi * 8); }

__device__ __forceinline__ void unit_D(LAS unsigned char* lds, const bf16* PROJ, const float* KMS  , bf16* MIXED, int b, int h, int own, int tid) {
    const int lane = tid & 63, wave = __builtin_amdgcn_readfirstlane(tid >> 6), r32 = lane & 31, hi = lane >> 5;
    const int t0 = own * 256, tq = t0 + wave * 32 + r32;
    const bf16* Pb = PROJ + (size_t)b * SEQ * NP;
    LAS float* KM = (LAS float*)(lds + 2 * SLOT);
    LAS unsigned* NEED = (LAS unsigned*)(lds + 2 * SLOT + 4096);
    __syncthreads();
    for (int i = tid; i < 1024; i += NTHR) KM[i] = KMS[(size_t)(b * 16 + (i >> 6)) * 256 + h * 64 + (i & 63)];
    bf16x8 qr[4]; load_q(qr, Pb + (size_t)tq * NP + PC_QD + h * 64, hi);
    __syncthreads();
    unsigned selbits = 0u;
    if (own > 0) {
        float g[16];
        UNR for (int n = 0; n < 16; ++n) {
            float s = 0.f;
            if (n < own) {
                UNR for (int d0 = 0; d0 < 4; ++d0) { const f32x4 k0 = *(const LAS f32x4*)(KM + n * 64 + d0 * 16 + hi * 8), k1 = *(const LAS f32x4*)(KM + n * 64 + d0 * 16 + hi * 8 + 4);
                    UNR for (int j = 0; j < 4; ++j) { s += bf1((bf16)qr[d0][j]) * k0[j] + bf1((bf16)qr[d0][4 + j]) * k1[j]; } }
                s = swapsum(s);
            }
            g[n] = (n < own) ? s : NEGF;
        }
        UNR for (int r = 0; r < 3; ++r) { float best = -INFINITY; int bi = 0;
            UNR for (int n = 0; n < 16; ++n) { if (!((selbits >> n) & 1u) && g[n] > best) { best = g[n]; bi = n; } }
            selbits |= 1u << bi; }
        selbits &= (1u << own) - 1u;
    }
    unsigned need = 0u;
    UNR for (int n = 0; n < 16; ++n) need |= (__ballot((selbits >> n) & 1u) != 0ull) ? (1u << n) : 0u;
    if (lane == 0) NEED[wave] = need;
    __syncthreads();
    unsigned needwg = 0u; UNR for (int w = 0; w < 8; ++w) needwg |= NEED[w];
    needwg |= 1u << own;
    const int kkey = lane, vkey = 16 * (wave & 3) + (lane >> 2);
    const bf16* kbase = Pb + PC_KD + h * 64 + wave * 8; const bf16* vbase = Pb + PC_VD + h * 64 + (wave >> 2) * 32 + (lane & 3) * 8;
    f32x16 o[2]; zero_o(o); float m = -1e30f, l = 0.f;
    const int Tend = 4 * own + 4;
    int T = 0; while (T < Tend && !((needwg >> (T >> 2)) & 1u)) T += 4;
    if (T < Tend) stage(kbase + (size_t)(64 * T + kkey) * NP, vbase + (size_t)(64 * T + vkey) * NP, lds, wave);
    __syncthreads();
    int buf = 0;
    while (T < Tend) {
        int Tn = T + 1; while (Tn < Tend && !((needwg >> (Tn >> 2)) & 1u)) Tn += 4 - (Tn & 3);
        if (Tn < Tend) stage(kbase + (size_t)(64 * Tn + kkey) * NP, vbase + (size_t)(64 * Tn + vkey) * NP, lds + (buf ^ 1) * SLOT, wave);
        const int n = T >> 2; const bool ownblk = (n == own);
        const bool active = ownblk ? (64 * T <= t0 + wave * 32 + 31) : (((need >> n) & 1u) != 0u);
        if (active) {
            f32x16 p0, p1; qk_tile(p0, p1, (lptr)(lds + buf * SLOT), qr, r32, hi);
            if (ownblk) { const int kb = 64 * T + 4 * hi;
                UNR for (int r = 0; r < 16; ++r) { const int kv = kb + (r & 3) + 8 * (r >> 2); if (kv > tq) p0[r] = -INFINITY; if (kv + 32 > tq) p1[r] = -INFINITY; } }
            else if (!((selbits >> n) & 1u)) { UNR for (int r = 0; r < 16; ++r) { p0[r] = -INFINITY; p1[r] = -INFINITY; } }
            softmax_step(p0, p1, m, l, o);
            pv_tile(o, (lptr)(lds + buf * SLOT + 8192), lane, p0, p1);
        }
        __syncthreads();
        T = Tn; buf ^= 1;
    }
    l = swapsum(l);
    store_gated_T(MIXED + ((size_t)b * SEQ + tq) * DM + 768 + h * 64, Pb + (size_t)tq * NP + PC_ZD + h * 64, o, 1.f / l, hi);
}

template <class Next, class Src, class Act, class Msk>
__device__ __forceinline__ void softmax_tiles(LAS unsigned char* lds, int lane, int wave, const bf16x8 (&qr)[4], f32x16 (&o)[2], float& m, float& l, int Tfirst, int Tend, Next next, Src src, Act act, Msk msk) {
    const int r32 = lane & 31, hi = lane >> 5;
    int T = Tfirst;
    if (T != Tend) { const bf16 *kp, *vp; src(T, kp, vp); stage(kp, vp, lds, wave); }
    __syncthreads();
    int buf = 0;
    while (T != Tend) {
        const int Tn = next(T);
        if (Tn != Tend) { const bf16 *kp, *vp; src(Tn, kp, vp); stage(kp, vp, lds + (buf ^ 1) * SLOT, wave); }
        if (act(T)) {
            f32x16 p0, p1; qk_tile(p0, p1, (lptr)(lds + buf * SLOT), qr, r32, hi);
            msk(T, p0, p1);
            softmax_step(p0, p1, m, l, o);
            pv_tile(o, (lptr)(lds + buf * SLOT + 8192), lane, p0, p1);
        }
        __syncthreads();
        T = Tn; buf ^= 1;
    }
}

__device__ __forceinline__ void sb_half(f32x16& p, int kbase, int hi, int tq, float& carry) {
    float L[16];
    UNR for (int r = 0; r < 16; ++r) { const int key = kbase + (r & 3) + 8 * (r >> 2) + 4 * hi; const float z2 = p[r] * C2, e = __builtin_amdgcn_exp2f(-fabsf(z2)), sp = __builtin_amdgcn_logf(1.f + e);
        L[r] = (key < tq) ? (fminf(-z2, 0.f) - sp) : 0.f; p[r] = fminf(z2, 0.f) - sp; }
    float G[4], O[4];
    UNR for (int g = 0; g < 4; ++g) { G[g] = (L[4 * g] + L[4 * g + 1]) + (L[4 * g + 2] + L[4 * g + 3]); O[g] = swapoth(G[g]); }
    float run = carry;
    UNR for (int g = 3; g >= 0; --g) {
        const float b3 = run + (hi == 0 ? O[g] : 0.f), b2 = b3 + L[4 * g + 3], b1 = b2 + L[4 * g + 2], b0 = b1 + L[4 * g + 1];
        const int key0 = kbase + 8 * g + 4 * hi;
        p[4 * g + 3] = (key0 + 3 < tq) ? __builtin_amdgcn_exp2f(p[4 * g + 3] + b3) : 0.f; p[4 * g + 2] = (key0 + 2 < tq) ? __builtin_amdgcn_exp2f(p[4 * g + 2] + b2) : 0.f;
        p[4 * g + 1] = (key0 + 1 < tq) ? __builtin_amdgcn_exp2f(p[4 * g + 1] + b1) : 0.f; p[4 * g + 0] = (key0 + 0 < tq) ? __builtin_amdgcn_exp2f(p[4 * g + 0] + b0) : 0.f;
        run += G[g] + O[g];
    }
    carry = run;
}
__device__ __forceinline__ void unit_A(LAS unsigned char* lds, const bf16* PROJ, bf16* MIXED, int b, int h, int qb, int tid) {
    const int lane = tid & 63, wave = __builtin_amdgcn_readfirstlane(tid >> 6), r32 = lane & 31, hi = lane >> 5;
    const int t0 = qb * 256, tq = t0 + wave * 32 + r32, wmax = t0 + wave * 32 + 31;
    const bf16* Pb = PROJ + (size_t)b * SEQ * NP;
    LAS unsigned* DN = (LAS unsigned*)(lds + 2 * SLOT);
    bf16x8 qr[4]; load_q(qr, Pb + (size_t)tq * NP + PC_QA + h * 64, hi);
    const int kkey = lane, vkey = 16 * (wave & 3) + (lane >> 2);
    const bf16* kbase = Pb + PC_KA + h * 64 + wave * 8; const bf16* vbase = Pb + PC_VA + h * 64 + (wave >> 2) * 32 + (lane & 3) * 8;
    f32x16 o[2]; zero_o(o); float carry = 0.f; bool done = false;
    int T = (t0 + 254) >> 6;
    __syncthreads();
    stage(kbase + (size_t)(64 * T + kkey) * NP, vbase + (size_t)(64 * T + vkey) * NP, lds, wave);
    __syncthreads();
    int buf = 0, it = 0;
    for (; T >= 0; --T, ++it) {
        if (T > 0) stage(kbase + (size_t)(64 * (T - 1) + kkey) * NP, vbase + (size_t)(64 * (T - 1) + vkey) * NP, lds + (buf ^ 1) * SLOT, wave);
        if (!done && 64 * T < wmax) {
            f32x16 p0, p1; qk_tile(p0, p1, (lptr)(lds + buf * SLOT), qr, r32, hi);
            sb_half(p1, 64 * T + 32, hi, tq, carry); sb_half(p0, 64 * T, hi, tq, carry);
            pv_tile(o, (lptr)(lds + buf * SLOT + 8192), lane, p0, p1);
            done = __all(carry < -50.f);
        }
        if (lane == 0) DN[(it & 1) * 8 + wave] = done ? 1u : 0u;
        __syncthreads();
        unsigned all = 1u; UNR for (int w = 0; w < 8; ++w) all &= DN[(it & 1) * 8 + w];
        buf ^= 1;
        if (all) break;
    }
    store_gated_T(MIXED + ((size_t)b * SEQ + tq) * DM + 0 + h * 64, Pb + (size_t)tq * NP + PC_ZA + h * 64, o, 1.f, hi);
}

__device__ __forceinline__ void unit_B(LAS unsigned char* lds, const bf16* PROJ, bf16* BO  , float* BL  , int cfg, int b, int h, int res, int i0, int tid) {
    const int lane = tid & 63, wave = __builtin_amdgcn_readfirstlane(tid >> 6), r32 = lane & 31, hi = lane >> 5;
    const int d = (cfg == 0) ? 1 : (cfg == 1 ? 4 : 16);
    const int qi = i0 + wave * 32 + r32, tq = res + d * qi, wlo = i0 + wave * 32 - 128, whi = i0 + wave * 32 + 31;
    const bf16* Pb = PROJ + (size_t)b * SEQ * NP;
    bf16x8 qr[4]; load_q(qr, Pb + (size_t)tq * NP + PC_QB + h * 64, hi);
    const int kkey = lane, vkey = 16 * (wave & 3) + (lane >> 2);
    const bf16* kbase = Pb + (size_t)res * NP + PC_KB + h * 64 + wave * 8; const bf16* vbase = Pb + (size_t)res * NP + PC_VB + h * 64 + (wave >> 2) * 32 + (lane & 3) * 8;
    f32x16 o[2]; zero_o(o); float m = -1e30f, l = 0.f;
    const int Tf = (i0 >= 128) ? ((i0 - 128) >> 6) : 0, Tend = ((i0 + 255) >> 6) + 1;
    __syncthreads();
    softmax_tiles(lds, lane, wave, qr, o, m, l, Tf, Tend,
        [&](int T) { return T + 1; },
        [&](int T, const bf16*& kp, const bf16*& vp) { kp = kbase + (size_t)(d * (64 * T + kkey)) * NP; vp = vbase + (size_t)(d * (64 * T + vkey)) * NP; },
        [&](int T) { return 64 * T <= whi && 64 * T + 63 >= wlo; },
        [&](int T, f32x16& p0, f32x16& p1) { const int kb = 64 * T + 4 * hi;
            UNR for (int r = 0; r < 16; ++r) { const int ki = kb + (r & 3) + 8 * (r >> 2); if (ki > qi || ki < qi - 128) p0[r] = -INFINITY; if (ki + 32 > qi || ki + 32 < qi - 128) p1[r] = -INFINITY; } });
    l = swapsum(l);
    const float il = 1.f / l; const size_t row = (size_t)b * SEQ + tq;
    bf16* orow = BO + ((size_t)cfg * MROWS + row) * 256 + h * 64;
    UNR for (int dh = 0; dh < 2; ++dh) UNR for (int g = 0; g < 4; ++g) { const int dd = 32 * dh + 8 * g + 4 * hi; v2u w; w.x = pk2(o[dh][4 * g] * il, o[dh][4 * g + 1] * il); w.y = pk2(o[dh][4 * g + 2] * il, o[dh][4 * g + 3] * il); *(v2u*)(orow + dd) = w; }
    if (hi == 0) BL[((size_t)cfg * MROWS + row) * 4 + h] = m * C2 + __builtin_amdgcn_logf(l);
}
__device__ __forceinline__ void b_combine(const bf16* PROJ, const bf16* BO, const float* BL, bf16* MIXED, int G, int vcu, int tid) {
    const int lane = tid & 63, wave = tid >> 6, h = lane >> 4;
    for (int row = vcu * NWAVES + wave; row < MROWS; row += G * NWAVES) {
        const float l0 = BL[((size_t)0 * MROWS + row) * 4 + h], l1 = BL[((size_t)1 * MROWS + row) * 4 + h], l2 = BL[((size_t)2 * MROWS + row) * 4 + h];
        const float mx = fmaxf(l0, fmaxf(l1, l2)); float w0 = __builtin_amdgcn_exp2f(l0 - mx), w1 = __builtin_amdgcn_exp2f(l1 - mx), w2 = __builtin_amdgcn_exp2f(l2 - mx);
        const float iw = 1.f / (w0 + w1 + w2); w0 *= iw; w1 *= iw; w2 *= iw;
        const v2u a = *(const v2u*)(BO + ((size_t)0 * MROWS + row) * 256 + 4 * lane), c = *(const v2u*)(BO + ((size_t)1 * MROWS + row) * 256 + 4 * lane), e = *(const v2u*)(BO + ((size_t)2 * MROWS + row) * 256 + 4 * lane);
        const v2u z = *(const v2u*)(PROJ + (size_t)row * NP + PC_ZB + 4 * lane);
        const float o0 = w0 * bflo(a.x) + w1 * bflo(c.x) + w2 * bflo(e.x), o1 = w0 * bfhi(a.x) + w1 * bfhi(c.x) + w2 * bfhi(e.x), o2 = w0 * bflo(a.y) + w1 * bflo(c.y) + w2 * bflo(e.y), o3 = w0 * bfhi(a.y) + w1 * bfhi(c.y) + w2 * bfhi(e.y);
        v2u w; w.x = pk2(o0 * siluf(bflo(z.x)), o1 * siluf(bfhi(z.x))); w.y = pk2(o2 * siluf(bflo(z.y)), o3 * siluf(bfhi(z.y)));
        *(v2u*)(MIXED + (size_t)row * DM + 256 + 4 * lane) = w;
    }
}

template <class Next, class Src, class Body>
__device__ __forceinline__ void tiles_loop(LAS unsigned char* lds, int wave, int Tfirst, int Tend, Next next, Src src, Body body) {
    int T = Tfirst;
    if (T != Tend) { const bf16 *kp, *vp; src(T, kp, vp); stage(kp, vp, lds, wave); }
    __syncthreads();
    int buf = 0;
    while (T != Tend) {
        const int Tn = next(T);
        if (Tn != Tend) { const bf16 *kp, *vp; src(Tn, kp, vp); stage(kp, vp, lds + (buf ^ 1) * SLOT, wave); }
        body(T, (lptr)(lds + buf * SLOT), (lptr)(lds + buf * SLOT + 8192));
        __syncthreads();
        T = Tn; buf ^= 1;
    }
}
__device__ __forceinline__ void unit_C(LAS unsigned char* lds, const bf16* PROJ, const bf16* KCB, const bf16* VCB, bf16* MIXED, int b, int qc, int tid) {
    const int lane = tid & 63, wave = __builtin_amdgcn_readfirstlane(tid >> 6), r32 = lane & 31, hi = lane >> 5;
    const int h = wave & 3, sub = wave >> 2, t0 = 64 * qc, q = 32 * sub + r32, tq = t0 + q;
    const bf16* Pb = PROJ + (size_t)b * SEQ * NP;
    LAS float* IMPH = (LAS float*)(lds + 2 * SLOT);
    LAS float* INVL = IMPH + 4 * 64 * 65;
    LAS unsigned long long* MSK = (LAS unsigned long long*)(lds + 2 * SLOT + 68608);
    bf16x8 qr[4]; load_q(qr, Pb + (size_t)tq * NP + PC_QC + h * 64, hi);
    const float g0 = sigmf(bf1(Pb[(size_t)tq * NP + PC_GC + h * 3 + 0])), g1 = sigmf(bf1(Pb[(size_t)tq * NP + PC_GC + h * 3 + 1])), g2 = sigmf(bf1(Pb[(size_t)tq * NP + PC_GC + h * 3 + 2]));
    const int kkey = lane, vkey = 16 * (wave & 3) + (lane >> 2), vcol = (wave >> 2) * 32 + (lane & 3) * 8;
    __syncthreads();
    for (int i = tid; i < 4 * 64 * 65; i += NTHR) IMPH[i] = 0.f;
    const int nv = (tq >= 31) ? (((tq - 31) >> 4) + 1) : 0;
    const int nvw = ((t0 + 32 * sub + 31 - 31) >> 4) + 1, nvwg = ((t0 + 63 - 31) >> 4) + 1;
    const int NTC = (nvwg + 63) >> 6;
    const bf16* kcb = KCB + (size_t)b * 256 * 64 + wave * 8; const bf16* vcb = VCB + (size_t)b * 256 * 64 + vcol;
    auto nextc = [&](int T) { return T + 1; };
    auto srcc = [&](int T, const bf16*& kp, const bf16*& vp) { kp = kcb + (size_t)(64 * T + kkey) * 64; vp = vcb + (size_t)(64 * T + vkey) * 64; };
    float m = -1e30f;
    tiles_loop(lds, wave, 0, NTC, nextc, srcc, [&](int T, lptr ks, lptr vs) {
        if (64 * T < nvw) { f32x16 p0, p1; qk_tile(p0, p1, ks, qr, r32, hi); const int nb = 64 * T + 4 * hi; float mx = -INFINITY;
            UNR for (int r = 0; r < 16; ++r) { const int n = nb + (r & 3) + 8 * (r >> 2); if (n < nv) mx = fmaxf(mx, p0[r]); if (n + 32 < nv) mx = fmaxf(mx, p1[r]); }
            m = fmaxf(m, swapmax(mx)); } });
    f32x16 o[2], res[2]; zero_o(o); float l = 0.f, pend = 0.f; const float nbias = -m * C2;
    tiles_loop(lds, wave, 0, NTC, nextc, srcc, [&](int T, lptr ks, lptr vs) {
        if (64 * T < nvw) { f32x16 p0, p1; qk_tile(p0, p1, ks, qr, r32, hi); const int nb = 64 * T + 4 * hi; float sum = 0.f;
            UNR for (int r = 0; r < 16; ++r) { const int n = nb + (r & 3) + 8 * (r >> 2);
                p0[r] = (n < nv) ? __builtin_amdgcn_exp2f(__builtin_fmaf(p0[r], C2, nbias)) : 0.f; p1[r] = (n + 32 < nv) ? __builtin_amdgcn_exp2f(__builtin_fmaf(p1[r], C2, nbias)) : 0.f; sum += p0[r] + p1[r]; }
            l += sum;
            UNR for (int half = 0; half < 2; ++half)
                UNR for (int g = 0; g < 4; ++g) { const f32x16& pp = half ? p1 : p0;
                    const float c = 0.5f * pp[4 * g + 3], w = (pp[4 * g] + pp[4 * g + 1]) + (pp[4 * g + 2] + c), oth = swapoth(c);
                    const float add = hi ? oth : pend; pend = oth;
                    const int sblk = 16 * T + 8 * half + 2 * g + hi;
                    IMPH[(h * 64 + sblk) * 65 + q] = w + add; }
            pv_tile(o, vs, lane, p0, p1); } });
    l = swapsum(l);
    { const float il = (l > 0.f) ? 1.f / l : 0.f; if (hi == 0) INVL[h * 64 + q] = il; UNR for (int r = 0; r < 16; ++r) { res[0][r] = g0 * il * o[0][r]; res[1][r] = g0 * il * o[1][r]; } }
    __syncthreads();
    for (int qq = 8 * wave; qq < 8 * wave + 8; ++qq) {
        float v = 0.f; UNR for (int hh = 0; hh < 4; ++hh) v += IMPH[(hh * 64 + lane) * 65 + qq] * INVL[hh * 64 + qq];
        const bool valid = lane <= qc, forced = (lane == 0) || (lane >= qc - 1);
        v = valid ? (forced ? 1e9f : v) : NEGF;
        int rank = 0;
        for (int sp = 0; sp < 64; ++sp) { const float vs = __int_as_float(__builtin_amdgcn_readlane(__float_as_int(v), sp)); rank += (vs > v || (vs == v && sp < lane)) ? 1 : 0; }
        const unsigned long long mk = __ballot(rank < 16);
        if (lane == 0) MSK[qq] = mk;
    }
    __syncthreads();
    const unsigned long long mq = MSK[q];
    unsigned long long needwg = MSK[lane];
    { unsigned lo = (unsigned)needwg, hh = (unsigned)(needwg >> 32); UNR for (int off = 32; off > 0; off >>= 1) { lo |= __shfl_xor(lo, off); hh |= __shfl_xor(hh, off); } needwg = ((unsigned long long)hh << 32) | lo; }
    needwg &= (qc >= 63) ? ~0ull : ((1ull << (qc + 1)) - 1ull);
    { zero_o(o); float ms = -1e30f, ls = 0.f;
      const bf16* kb = Pb + PC_KSR + wave * 8; const bf16* vb = Pb + PC_VSR + vcol;
      int Tf = 0; while (Tf <= qc && !((needwg >> Tf) & 1ull)) ++Tf;
      softmax_tiles(lds, lane, wave, qr, o, ms, ls, Tf, qc + 1,
          [&](int T) { int Tn = T + 1; while (Tn <= qc && !((needwg >> Tn) & 1ull)) ++Tn; return Tn; },
          [&](int T, const bf16*& kp, const bf16*& vp) { kp = kb + (size_t)(64 * T + kkey) * NP; vp = vb + (size_t)(64 * T + vkey) * NP; },
          [&](int T) { return __ballot((mq >> T) & 1ull) != 0ull; },
          [&](int T, f32x16& p0, f32x16& p1) { const bool sel = ((mq >> T) & 1ull) != 0ull; const int kb0 = 64 * T + 4 * hi;
              UNR for (int r = 0; r < 16; ++r) { const int kv = kb0 + (r & 3) + 8 * (r >> 2); if (!sel || kv > tq) p0[r] = -INFINITY; if (!sel || kv + 32 > tq) p1[r] = -INFINITY; } });
      ls = swapsum(ls); const float il = g1 / ls; UNR for (int r = 0; r < 16; ++r) { res[0][r] += il * o[0][r]; res[1][r] += il * o[1][r]; } }
    { zero_o(o); float mw = -1e30f, lw = 0.f;
      const bf16* kb = Pb + PC_KWR + wave * 8; const bf16* vb = Pb + PC_VWR + vcol;
      softmax_tiles(lds, lane, wave, qr, o, mw, lw, (qc >= 8) ? qc - 8 : 0, qc + 1,
          [&](int T) { return T + 1; },
          [&](int T, const bf16*& kp, const bf16*& vp) { kp = kb + (size_t)(64 * T + kkey) * NP; vp = vb + (size_t)(64 * T + vkey) * NP; },
          [&](int T) { return true; },
          [&](int T, f32x16& p0, f32x16& p1) { const int kb0 = 64 * T + 4 * hi;
              UNR for (int r = 0; r < 16; ++r) { const int kv = kb0 + (r & 3) + 8 * (r >> 2); if (kv > tq || kv < tq - 511) p0[r] = -INFINITY; if (kv + 32 > tq || kv + 32 < tq - 511) p1[r] = -INFINITY; } });
      lw = swapsum(lw); const float il = g2 / lw; UNR for (int r = 0; r < 16; ++r) { res[0][r] += il * o[0][r]; res[1][r] += il * o[1][r]; } }
    store_gated_T(MIXED + ((size_t)b * SEQ + tq) * DM + 512 + h * 64, Pb + (size_t)tq * NP + PC_ZC + h * 64, res, 1.f, hi);
}

__device__ __forceinline__ void unit_cmp(LAS unsigned char* lds, const bf16* PROJ, const bf16* W1T  , const bf16* W2T  , const float* POSP  , const float* b1  ,
                                         const float* COSC, const float* SINC, bf16* KCB, bf16* VCB, int kv, int b, int nt, int tid) {
    const int lane = tid & 63, wave = __builtin_amdgcn_readfirstlane(tid >> 6), r32 = lane & 31, hi = lane >> 5;
    const int n0 = 32 * nt, na = (n0 + r32 < 255) ? n0 + r32 : 254;
    const bf16* arow = PROJ + ((size_t)b * SEQ + 16 * na) * NP + (kv ? PC_VCR : PC_KCR);
    const bf16* brow = W1T + ((size_t)kv * 256 + 32 * wave + r32) * 2048;
    f32x16 acc; UNR for (int r = 0; r < 16; ++r) acc[r] = 0.f;
#pragma unroll 8
    for (int ks = 0; ks < 128; ++ks) { const int i0 = 16 * ks + 8 * hi;
        const bf16x8 a = *(const bf16x8*)(arow + (size_t)(i0 >> 6) * NP + (i0 & 63)), w = *(const bf16x8*)(brow + i0);
        acc = __builtin_amdgcn_mfma_f32_32x32x16_bf16(a, w, acc, 0, 0, 0); }
    const int u = 32 * wave + r32; float bs = b1[kv * 256 + u];
    UNR for (int c = 0; c < 16; ++c) bs += POSP[(kv * 16 + c) * 256 + u];
    LAS bf16* HL = (LAS bf16*)lds;
    __syncthreads();
    UNR for (int r = 0; r < 16; ++r) HL[((r & 3) + 8 * (r >> 2) + 4 * hi) * 264 + u] = (bf16)f2bf(gelu_tanh(acc[r] + bs));
    __syncthreads();
    if (wave < 2) {
        const bf16* wrow = W2T + ((size_t)kv * 64 + 32 * wave + r32) * 256;
        f32x16 o; UNR for (int r = 0; r < 16; ++r) o[r] = 0.f;
        UNR for (int k2 = 0; k2 < 16; ++k2) { const bf16x8 a = *(const LAS bf16x8*)(HL + r32 * 264 + 16 * k2 + 8 * hi), w = *(const bf16x8*)(wrow + 16 * k2 + 8 * hi);
            o = __builtin_amdgcn_mfma_f32_32x32x16_bf16(a, w, o, 0, 0, 0); }
        const int d = 32 * wave + r32;
        UNR for (int r = 0; r < 16; ++r) { const int n = n0 + (r & 3) + 8 * (r >> 2) + 4 * hi; float v = o[r];
            if (kv == 0 && wave == 0) { const float oth = __shfl_xor(v, 8); if (d < 8) v = v * COSC[n * 8 + d] - oth * SINC[n * 8 + d]; else if (d < 16) v = v * COSC[n * 8 + d - 8] + oth * SINC[n * 8 + d - 8]; }
            (kv ? VCB : KCB)[((size_t)b * 256 + n) * 64 + d] = (bf16)f2bf(v); }
    }
}
}
struct Args { const float* in[12]; float* out; unsigned char* ws; int ph_lo, ph_hi; float rf[8]; };
typedef const __attribute__((address_space(4))) Args* KArgs;
__device__ __forceinline__ KArgs kargs() { KArgs p = (KArgs)__builtin_amdgcn_kernarg_segment_ptr(); asm volatile("" : "+s"(p)); return p; }
constexpr int PPL = 5, N_PHASES = 2 + PPL * DEPTH;
#define PH_TID() int tid_ = threadIdx.x; asm volatile("" : "+v"(tid_)); const int half = tid_ >> 8, lt = tid_ & 255, lane_ = tid_ & 63; (void)half; (void)lt; (void)lane_

__device__ __forceinline__ void ph_inproj(Frame& F, int l) {
    KArgs ka = kargs(); unsigned char* ws = ka->ws;
    pg8::Gemm g{(const bf16*)(ws + WS_XN), (const bf16*)(ws + WS_WIN) + (size_t)l * NP * DM, MROWS, NP, DM}; pg8::StaticOrder S; S.init(MROWS, NP, F.G, (int)blockIdx.x);
    pg8::EpiProj E{(bf16*)(ws + WS_PROJ), NP, (const float*)(ws + WS_COS), (const float*)(ws + WS_SIN), (float*)(ws + WS_KMSUM) + (size_t)l * 64 * 256};
    pg8::gemm_phase<pg8::EpiProj, pg8::StaticOrder, PG8_ALIGN, PG8_SP2>(F.lds, g, S, E);
}
__device__ __forceinline__ void ph_outproj(Frame& F, int l) {
    KArgs ka = kargs(); unsigned char* ws = ka->ws;
    pg8::Gemm g{(const bf16*)(ws + WS_MIXED), (const bf16*)(ws + WS_WOUT) + (size_t)l * DM * DM, MROWS, DM, DM}; pg8::StaticOrder S; S.init(MROWS, DM, F.G, (int)blockIdx.x);
    pg8::EpiBf16<0> E{(bf16*)(ws + WS_Y), DM, nullptr, 0, 0, 1.f};
    pg8::gemm_phase<pg8::EpiBf16<0>, pg8::StaticOrder, PG8_ALIGN, PG8_SP2>(F.lds, g, S, E);
}
#ifndef MX_D
#define MX_D 1
#endif
#ifndef MX_A
#define MX_A 1
#endif
#ifndef MX_B
#define MX_B 1
#endif
#ifndef MX_C
#define MX_C 1
#endif
#ifndef MX_CMP
#define MX_CMP 1
#endif
__device__ __forceinline__ void ph_mixers(Frame& F, int l) {
    KArgs ka = kargs(); unsigned char* ws = ka->ws; PH_TID();
    const bf16* PROJ = (const bf16*)(ws + WS_PROJ); bf16* MIXED = (bf16*)(ws + WS_MIXED); const float* KMS = (const float*)(ws + WS_KMSUM) + (size_t)l * 64 * 256;
    bf16* KCB = (bf16*)(ws + WS_KCB); bf16* VCB = (bf16*)(ws + WS_VCB); bf16* BO = (bf16*)(ws + WS_BO); float* BL = (float*)(ws + WS_BL);
    unsigned* qctr = (unsigned*)(ws + WS_CTL) + CW_Q + l * 128; unsigned* cdone = qctr + 64;
    LAS int* QW = (LAS int*)(F.lds + RING_BYTES + 64);
    constexpr int U_CMP = 64, U_D = 256, U_C = 256, U_B = 768, U_A = 256, NU = U_CMP + U_D + U_C + U_B + U_A;
    for (;;) {
        __syncthreads();
        if (tid_ == 0) QW[0] = (int)__hip_atomic_fetch_add(qctr, 1u, __ATOMIC_RELAXED, __HIP_MEMORY_SCOPE_AGENT);
        __syncthreads();
        int u = QW[0];
        if (u >= NU) break;
        if (u < U_CMP) {
#if MX_CMP
            att::unit_cmp(F.lds, PROJ, (const bf16*)(ws + WS_W1T) + (size_t)l * 2 * 256 * 2048, (const bf16*)(ws + WS_W2T) + (size_t)l * 2 * 64 * 256, (const float*)(ws + WS_POSP) + (size_t)l * 2 * 16 * 256,
                          ka->in[10] + l * 2 * 256, (const float*)(ws + WS_COSC), (const float*)(ws + WS_SINC), KCB, VCB, u >> 5, (u >> 3) & 3, u & 7, tid_);
            asm volatile("s_waitcnt vmcnt(0)" ::: "memory"); __syncthreads();
            if (tid_ == 0) { __builtin_amdgcn_fence(__ATOMIC_RELEASE, "agent"); asm volatile("s_waitcnt vmcnt(0)" ::: "memory"); __hip_atomic_fetch_add(cdone, 1u, __ATOMIC_RELAXED, __HIP_MEMORY_SCOPE_AGENT); }
#endif
            continue; }
        u -= U_CMP;
        if (u < U_D) {
#if MX_D
            att::unit_D(F.lds, PROJ, KMS, MIXED, (u >> 2) & 3, u & 3, 15 - (u >> 4), tid_);
#endif
            continue; }
        u -= U_D;
        if (u < U_C) {
#if MX_C
#if MX_CMP
            if (tid_ == 0) { unsigned sp = 0; while (__hip_atomic_load(cdone, __ATOMIC_RELAXED, __HIP_MEMORY_SCOPE_AGENT) < (unsigned)U_CMP) { __builtin_amdgcn_s_sleep(8); if (++sp > (1u << 22)) break; }
                __builtin_amdgcn_fence(__ATOMIC_ACQUIRE, "agent"); asm volatile("s_waitcnt vmcnt(0)" ::: "memory"); }
            __syncthreads();
#endif
            att::unit_C(F.lds, PROJ, KCB, VCB, MIXED, u & 3, 63 - (u >> 2), tid_);
#endif
            continue; }
        u -= U_C;
        if (u < U_B) {
#if MX_B
            const int cfg = u >> 8, v = u & 255, bb = v >> 6, h = (v >> 4) & 3, w = v & 15;
            const int res = (cfg == 0) ? 0 : (cfg == 1 ? (w & 3) : w), i0 = (cfg == 0) ? 256 * w : (cfg == 1 ? 256 * (w >> 2) : 0);
            att::unit_B(F.lds, PROJ, BO, BL, cfg, bb, h, res, i0, tid_);
#endif
            continue; }
        u -= U_B;
#if MX_A
        att::unit_A(F.lds, PROJ, MIXED, (u >> 2) & 3, u & 3, 15 - (u >> 4), tid_);
#endif
    }
}
__device__ __forceinline__ void ph_bcomb(Frame& F, int l) {
#if MX_B
    KArgs ka = kargs(); unsigned char* ws = ka->ws; PH_TID();
    att::b_combine((const bf16*)(ws + WS_PROJ), (const bf16*)(ws + WS_BO), (const float*)(ws + WS_BL), (bf16*)(ws + WS_MIXED), F.G, F.vcu, tid_);
#endif
}
__device__ __forceinline__ void ph_final(Frame& F, int l) {
    KArgs ka = kargs(); unsigned char* ws = ka->ws;
    const float* MOD = (const float*)(ws + WS_MOD); const float* npre = ka->in[2]; const float* npost = ka->in[3]; float* out = ka->out;
    final_rows(F, (const bf16*)(ws + WS_Y), l == 0 ? ka->in[0] : (const float*)out, npost + l * DM, MOD + (size_t)l * NB * 3072, out, l + 1 < DEPTH, npre + (l + 1) * DM, MOD + (size_t)(l + 1) * NB * 3072, (bf16*)(ws + WS_XN));
}

__global__ void __launch_bounds__(NTHR, 2) mk_fwd(Args args_unused) {
    extern __shared__ __attribute__((aligned(16))) unsigned char lds[];
    Frame F;
    F.lds = (LAS unsigned char*)lds;
    F.tid = threadIdx.x; F.lane = F.tid & 63; F.wave = __builtin_amdgcn_readfirstlane(F.tid >> 6);
    F.G = gridDim.x; { const int bx = blockIdx.x; F.vcu = (F.G % 8 == 0) ? (bx % 8) * (F.G / 8) + bx / 8 : bx; }
    for (int u = F.tid; u < (LDS_BYTES - RING_BYTES) / 4; u += NTHR) ((LAS unsigned*)(F.lds + RING_BYTES))[u] = 0u;
    __syncthreads();
    int lo, hi; XcdBarrier bar;
    { KArgs ka = kargs(); lo = ka->ph_lo; hi = ka->ph_hi; F.ws = nullptr;
      unsigned* ctl = (unsigned*)(ka->ws + WS_CTL); bar.bar = ctl + CW_BAR; bar.x = 0; bar.st = nullptr;
      if (hi - lo > 1) bar = xcd_barrier_post(ctl + CW_BAR, (volatile LAS unsigned*)(F.lds + MISC_OFF) + 8); }
#define IN(k) (lo <= (k) && (k) < hi)
#define SEAM(k) do { if (IN(k) && IN((k) + 1)) { xcd_barrier(bar); } } while (0)
    if (IN(0)) { KArgs ka = kargs(); F.ws = ka->ws; float rf[8]; UNR for (int i = 0; i < 8; ++i) rf[i] = ka->rf[i];
        p0_prologue(F, ka->in[6], ka->in[7], ka->in[1], ka->in[4], ka->in[5], ka->in[8], ka->in[9], ka->in[11], rf); } SEAM(0);
    if (IN(1)) { KArgs ka = kargs(); unsigned char* ws = ka->ws; xn_rows(F, ka->in[0], ka->in[2], (const float*)(ws + WS_MOD), (bf16*)(ws + WS_XN)); } SEAM(1);
#define LAYER(l) do { const int pb = 2 + PPL * (l); \
    if (IN(pb)) ph_inproj(F, (l)); SEAM(pb); \
    if (IN(pb + 1)) ph_mixers(F, (l)); SEAM(pb + 1); \
    if (IN(pb + 2)) ph_bcomb(F, (l)); SEAM(pb + 2); \
    if (IN(pb + 3)) ph_outproj(F, (l)); SEAM(pb + 3); \
    if (IN(pb + 4)) ph_final(F, (l)); SEAM(pb + 4); } while (0)
    LAYER(0); LAYER(1);
#undef LAYER
#undef IN
#undef SEAM
}

__global__ void __launch_bounds__(256) nk_cmp1(const bf16* PROJ, const float* cpos, const float* w1, const float* b1, float* HID) {
    __shared__ float blk[2048];
    const int u = blockIdx.x, kv = blockIdx.y, b = u / 255, n = u % 255, lt = threadIdx.x, col = kv ? PC_VCR : PC_KCR; const bf16* P = PROJ + (size_t)b * SEQ * NP;
    for (int i = lt; i < 2048; i += 256) { const int j = i / 64, d = i % 64; blk[i] = bf1(P[(size_t)(16 * n + j) * NP + col + d]) + cpos[(kv * 32 + j) * 64 + d]; }
    __syncthreads();
    float acc = 0.f; const float* w = w1 + (size_t)kv * 2048 * 256 + lt;
    for (int i = 0; i < 2048; ++i) acc += blk[i] * w[(size_t)i * 256];
    HID[((size_t)(kv * NB + b) * 256 + n) * 256 + lt] = gelu_tanh(acc + b1[kv * 256 + lt]);
}
__global__ void __launch_bounds__(64) nk_cmp2(const float* HID, const float* w2, const float* COSC, const float* SINC, float* KCF, float* VCF, bf16* KCB, bf16* VCB) {
    const int u = blockIdx.x, kv = blockIdx.y, b = u / 255, n = u % 255, d = threadIdx.x;
    const float* hr = HID + ((size_t)(kv * NB + b) * 256 + n) * 256; const float* w = w2 + (size_t)kv * 256 * 64 + d;
    float acc = 0.f; for (int k = 0; k < 256; ++k) acc += hr[k] * w[k * 64];
    const float oth = __shfl_xor(acc, 8);
    if (kv == 0) { float r = acc; if (d < 8) r = acc * COSC[n * 8 + d] - oth * SINC[n * 8 + d]; else if (d < 16) r = acc * COSC[n * 8 + d - 8] + oth * SINC[n * 8 + d - 8]; KCF[((size_t)b * 256 + n) * 64 + d] = r; KCB[((size_t)b * 256 + n) * 64 + d] = (bf16)f2bf(r); }
    else { VCF[((size_t)b * 256 + n) * 64 + d] = acc; VCB[((size_t)b * 256 + n) * 64 + d] = (bf16)f2bf(acc); }
}
__global__ void __launch_bounds__(256) nk_A(const bf16* PROJ, bf16* MIXED) { const int b = blockIdx.z, h = blockIdx.y, t0 = blockIdx.x * 256; nv_A(PROJ + (size_t)b * SEQ * NP, MIXED + (size_t)b * SEQ * DM, h, t0, t0 + threadIdx.x); }
__global__ void __launch_bounds__(256) nk_B(const bf16* PROJ, bf16* MIXED) { const int b = blockIdx.z, h = blockIdx.y, t0 = blockIdx.x * 256; nv_B(PROJ + (size_t)b * SEQ * NP, MIXED + (size_t)b * SEQ * DM, h, t0 + threadIdx.x); }
__global__ void __launch_bounds__(256) nk_D(const bf16* PROJ, const float* KMS, bf16* MIXED) { const int b = blockIdx.z, h = blockIdx.y, t0 = blockIdx.x * 256; nv_D(PROJ + (size_t)b * SEQ * NP, KMS + (size_t)b * 16 * 256, MIXED + (size_t)b * SEQ * DM, h, t0, t0 + threadIdx.x); }
__global__ void __launch_bounds__(256) nk_C1(const bf16* PROJ, const float* KCF, float* PCN) { const int b = blockIdx.z, h = blockIdx.y, t0 = blockIdx.x * 256; nv_C1(PROJ + (size_t)b * SEQ * NP, KCF + (size_t)b * 256 * 64, PCN + (size_t)b * 4 * SEQ * 256, h, t0 + threadIdx.x); }
__global__ void __launch_bounds__(128) nk_C2(const float* PCN, unsigned long long* SELM) { __shared__ float imp[64 * 128]; const int row = blockIdx.x * 128 + threadIdx.x, b = row / SEQ, t = row % SEQ;
    nv_C2<128>(PCN + (size_t)b * 4 * SEQ * 256, SELM + (size_t)b * SEQ, (LAS float*)imp + threadIdx.x, t); }
__global__ void __launch_bounds__(256) nk_C3(const bf16* PROJ, const float* PCN, const float* VCF, const unsigned long long* SELM, bf16* MIXED) { __shared__ float res[64 * 256];
    const int b = blockIdx.z, h = blockIdx.y, t0 = blockIdx.x * 256;
    nv_C3<256>(PROJ + (size_t)b * SEQ * NP, PCN + (size_t)b * 4 * SEQ * 256, VCF + (size_t)b * 256 * 64, SELM + (size_t)b * SEQ, MIXED + (size_t)b * SEQ * DM, (LAS float*)res + threadIdx.x, h, t0, t0 + threadIdx.x); }

#ifndef MK_ONE_LAUNCH
#define MK_ONE_LAUNCH 1
#endif
#ifndef NAIVE_A
#define NAIVE_A 1
#define NAIVE_B 1
#define NAIVE_C 1
#define NAIVE_D (!MX_D)
#undef NAIVE_A
#define NAIVE_A (!MX_A)
#undef NAIVE_C
#define NAIVE_C (!MX_C)
#define NAIVE_CMP (!MX_CMP)
#undef NAIVE_B
#define NAIVE_B (!MX_B)
#endif
extern "C" void kernel_launch(void* const* d_in, const int* in_sizes, int n_in, void* d_out, int out_size, void* d_ws, size_t ws_size, hipStream_t stream) {
    static int grid = 0;
    if (grid == 0) {
        if (n_in != 12 || out_size != MROWS * DM || ws_size < WS_END) { fprintf(stderr, "kernel_launch: unexpected shapes (n_in %d out %d ws %zu)\n", n_in, out_size, ws_size); grid = -1; return; }
        int dev = 0, cus = 0;
        if (hipGetDevice(&dev) != hipSuccess || hipDeviceGetAttribute(&cus, hipDeviceAttributeMultiprocessorCount, dev) != hipSuccess) { grid = -1; return; }
        if (hipFuncSetAttribute((const void*)mk_fwd, hipFuncAttributeMaxDynamicSharedMemorySize, LDS_BYTES) != hipSuccess) { fprintf(stderr, "kernel_launch: hipFuncSetAttribute failed\n"); grid = -1; return; }
        grid = cus;
    }
    if (grid < 0) return;
    (void)hipMemsetAsync((char*)d_ws + WS_CTL, 0, CTL_BYTES, stream);
    Args a{};
    for (int i = 0; i < 12; ++i) a.in[i] = (const float*)d_in[i];
    a.out = (float*)d_out; a.ws = (unsigned char*)d_ws;
    for (int i = 0; i < 8; ++i) { const float tt = powf(500000.0f, (float)(2 * i) / 16.0f); a.rf[i] = 1.0f / tt; }
    auto run = [&](int plo, int phi) { a.ph_lo = plo; a.ph_hi = phi; hipLaunchKernelGGL(mk_fwd, dim3(grid), dim3(NTHR), LDS_BYTES, stream, a); };
#if MK_ONE_LAUNCH
    run(0, N_PHASES);
#else
    unsigned char* ws = (unsigned char*)d_ws;
    bf16* PROJ = (bf16*)(ws + WS_PROJ); bf16* MIXED = (bf16*)(ws + WS_MIXED); float* HID = (float*)(ws + WS_HID); float* KCF = (float*)(ws + WS_KCF); float* VCF = (float*)(ws + WS_VCF);
    float* PCN = (float*)(ws + WS_PCN); unsigned long long* SELM = (unsigned long long*)(ws + WS_SELM);
    run(0, 1); run(1, 2);
    for (int l = 0; l < DEPTH; ++l) {
        const int pb = 2 + PPL * l; const float* KMS = (const float*)(ws + WS_KMSUM) + (size_t)l * 64 * 256;
        run(pb, pb + 1);
#if NAIVE_CMP
        nk_cmp1<<<dim3(NB * 255, 2), 256, 0, stream>>>(PROJ, (const float*)d_in[8] + (size_t)l * 2 * 32 * 64, (const float*)d_in[9] + (size_t)l * 2 * 2048 * 256, (const float*)d_in[10] + l * 2 * 256, HID);
        nk_cmp2<<<dim3(NB * 255, 2), 64, 0, stream>>>(HID, (const float*)d_in[11] + (size_t)l * 2 * 256 * 64, (const float*)(ws + WS_COSC), (const float*)(ws + WS_SINC), KCF, VCF, (bf16*)(ws + WS_KCB), (bf16*)(ws + WS_VCB));
#endif
        run(pb + 1, pb + 2); run(pb + 2, pb + 3);
#if NAIVE_A
        nk_A<<<dim3(16, 4, NB), 256, 0, stream>>>(PROJ, MIXED);
#endif
#if NAIVE_B
        nk_B<<<dim3(16, 4, NB), 256, 0, stream>>>(PROJ, MIXED);
#endif
#if NAIVE_D
        nk_D<<<dim3(16, 4, NB), 256, 0, stream>>>(PROJ, KMS, MIXED);
#endif
#if NAIVE_C
        nk_C1<<<dim3(16, 4, NB), 256, 0, stream>>>(PROJ, KCF, PCN);
        nk_C2<<<MROWS / 128, 128, 0, stream>>>(PCN, SELM);
        nk_C3<<<dim3(16, 4, NB), 256, 0, stream>>>(PROJ, PCN, VCF, SELM, MIXED);
#endif
        run(pb + 3, pb + 4); run(pb + 4, pb + 5);
    }
#endif
}
```
